# Optimizing an MI355X kernel written in HIP

```python
import math
import jax
import jax.numpy as jnp
from jax import lax
import numpy as np

D_MODEL = 2048
BATCH = 8
SEQ = 2048
DEPTH = 2

HYENA_WIDTH = D_MODEL // 2
HYENA_ORDER = 2
HYENA_DIRS = 2
SHORT_CONV = 3
FILTER_EMB = 33
FILTER_BANDS = (FILTER_EMB - 1) // 2
FILTER_HIDDEN = 64
FILTER_SIN_W = 1.0
DECAY_TARGET = 1e-2
FAST_DECAY_PCT = 0.3
SLOW_DECAY_PCT = 1.5
MIN_DECAY = math.log(DECAY_TARGET) / FAST_DECAY_PCT
MAX_DECAY = math.log(DECAY_TARGET) / SLOW_DECAY_PCT

HEAD_DIM = 128
N_HEADS = (D_MODEL // 2) // HEAD_DIM
N_KV_HEADS = 2
GROUP = N_HEADS // N_KV_HEADS
ATTN_WIDTH = N_HEADS * HEAD_DIM
KV_WIDTH = N_KV_HEADS * HEAD_DIM
WINDOW = 128
BLOCK = 128
ROPE_THETA = 500000.0
ROPE_DIM = HEAD_DIM // 4
EPS = 1e-6

IN_SIZES = ((HYENA_ORDER + 1) * HYENA_WIDTH, HYENA_WIDTH, ATTN_WIDTH, KV_WIDTH, KV_WIDTH, ATTN_WIDTH, D_MODEL, D_MODEL)
IN_WIDTH = sum(IN_SIZES)

kernel_name = "hyena_swa_gated_hybrid_encoder"


def rms_norm(x, g):
    xf = x.astype(jnp.float32)
    y = xf * lax.rsqrt(jnp.mean(xf * xf, axis=-1, keepdims=True) + EPS)
    return (y * g.astype(jnp.float32)).astype(x.dtype)


def short_conv_centred(u, w, b):
    L = u.shape[1]
    p = SHORT_CONV // 2
    up = jnp.pad(u, ((0, 0), (p, SHORT_CONV - 1 - p), (0, 0)))
    out = b
    for j in range(SHORT_CONV):
        out = out + up[:, j:j + L] * w[j]
    return out


def hyena_kernels(L, w1, b1, w2, b2, w3, b3, w4, freq):
    f32 = jnp.float32
    t = jnp.linspace(0.0, 1.0, L, dtype=f32)[:, None]
    bands = jnp.linspace(1e-4, FILTER_BANDS - 1, FILTER_BANDS, dtype=f32)[None, :]
    ang = (2.0 * math.pi / L) * jnp.arange(L, dtype=f32)[:, None] * bands
    feats = jnp.concatenate([t, jnp.cos(ang), -jnp.sin(ang)], axis=-1)
    fr = freq.astype(f32)
    hdn = jnp.sin(fr * (feats @ w1.astype(f32) + b1.astype(f32)))
    hdn = jnp.sin(fr * (hdn @ w2.astype(f32) + b2.astype(f32)))
    hdn = jnp.sin(fr * (hdn @ w3.astype(f32) + b3.astype(f32)))
    filt = (hdn @ w4.astype(f32)).reshape(L, HYENA_ORDER, HYENA_DIRS, HYENA_WIDTH)
    deltas = jnp.abs(jnp.linspace(MIN_DECAY, MAX_DECAY, HYENA_WIDTH, dtype=f32))
    filt = filt * jnp.exp(-t * deltas)[:, None, None, :]
    fwd = filt[:, :, 0]
    bwd = filt[:, :, 1]
    zero = jnp.zeros((1, HYENA_ORDER, HYENA_WIDTH), f32)
    return jnp.concatenate([fwd, zero, bwd[1:][::-1]], axis=0)


def long_conv(u, kern2l, bias):
    L = u.shape[1]
    uf = jnp.fft.rfft(u.astype(jnp.float32), n=2 * L, axis=1)
    kf = jnp.fft.rfft(kern2l, n=2 * L, axis=0)
    y = jnp.fft.irfft(uf * kf[None], n=2 * L, axis=1)[:, :L]
    return (y + u.astype(jnp.float32) * bias.astype(jnp.float32)).astype(u.dtype)


def rope_partial(x, cos, sin):
    half = ROPE_DIM // 2
    xf = x.astype(jnp.float32)
    x1 = xf[..., :half]
    x2 = xf[..., half:ROPE_DIM]
    rot = jnp.concatenate([x1 * cos - x2 * sin, x2 * cos + x1 * sin], axis=-1)
    return jnp.concatenate([rot, xf[..., ROPE_DIM:]], axis=-1).astype(x.dtype)


def rope_tables(L):
    inv = ROPE_THETA ** (-jnp.arange(0, ROPE_DIM, 2, dtype=jnp.float32) / ROPE_DIM)
    ang = jnp.arange(L, dtype=jnp.float32)[:, None] * inv[None, :]
    return jnp.cos(ang)[:, None, :], jnp.sin(ang)[:, None, :]


def banded_sink_attention(q, k, v, sink):
    B, L = q.shape[0], q.shape[1]
    nb = L // BLOCK
    qb = q.reshape(B, nb, BLOCK, N_KV_HEADS, GROUP, HEAD_DIM)
    pad = ((0, 0), (BLOCK, BLOCK), (0, 0), (0, 0))
    kb = jnp.pad(k, pad).reshape(B, nb + 2, BLOCK, N_KV_HEADS, HEAD_DIM)
    vb = jnp.pad(v, pad).reshape(B, nb + 2, BLOCK, N_KV_HEADS, HEAD_DIM)
    kw = jnp.concatenate([kb[:, :-2], kb[:, 1:-1], kb[:, 2:]], axis=2)
    vw = jnp.concatenate([vb[:, :-2], vb[:, 1:-1], vb[:, 2:]], axis=2)
    s = jnp.einsum("bnqkgd,bnskd->bnkgqs", qb, kw, preferred_element_type=jnp.float32)
    s = s * (HEAD_DIM ** -0.5)
    blk = jnp.arange(nb)[:, None, None]
    qpos = blk * BLOCK + jnp.arange(BLOCK)[None, :, None]
    kpos = (blk - 1) * BLOCK + jnp.arange(3 * BLOCK)[None, None, :]
    valid = (jnp.abs(kpos - qpos) <= WINDOW) & (kpos >= 0) & (kpos < L)
    s = jnp.where(valid[None, :, None, None], s, -jnp.inf)
    sk = sink.astype(jnp.float32).reshape(1, 1, N_KV_HEADS, GROUP, 1, 1)
    m = jnp.maximum(jnp.max(s, axis=-1, keepdims=True), sk)
    p = jnp.exp(s - m)
    p = p / (jnp.sum(p, axis=-1, keepdims=True) + jnp.exp(sk - m))
    o = jnp.einsum("bnkgqs,bnskd->bnqkgd", p.astype(vw.dtype), vw)
    return o.reshape(B, L, N_HEADS * HEAD_DIM)


def hybrid_layer(x, norm_g, w_in, conv_w, conv_b, filt_w1, filt_b1, filt_w2, filt_b2,
                 filt_w3, filt_b3, filt_w4, filt_freq, hyena_bias, attn_sink,
                 w_hyena_out, w_attn_out, w_out):
    B, L, _ = x.shape
    h = rms_norm(x, norm_g)
    proj = h @ w_in
    points = np.cumsum(IN_SIZES)[:-1].tolist()
    u_hy, z_hy, q, k, v, z_at, g_hy, g_at = jnp.split(proj, points, axis=-1)

    u_hy = short_conv_centred(u_hy, conv_w, conv_b)
    hv, hx1, hx2 = jnp.split(u_hy, HYENA_ORDER + 1, axis=-1)
    kern = hyena_kernels(L, filt_w1, filt_b1, filt_w2, filt_b2, filt_w3, filt_b3, filt_w4, filt_freq)
    z = hx1 * long_conv(hv, kern[:, 0], hyena_bias[0])
    y_hy = hx2 * long_conv(z, kern[:, 1], hyena_bias[1])
    y_hy = y_hy * jax.nn.silu(z_hy)

    cos, sin = rope_tables(L)
    q = rope_partial(q.reshape(B, L, N_HEADS, HEAD_DIM), cos, sin)
    k = rope_partial(k.reshape(B, L, N_KV_HEADS, HEAD_DIM), cos, sin)
    v = v.reshape(B, L, N_KV_HEADS, HEAD_DIM)
    y_at = banded_sink_attention(q, k, v, attn_sink) * jax.nn.silu(z_at)

    merged = jax.nn.sigmoid(g_hy) * (y_hy @ w_hyena_out) + jax.nn.sigmoid(g_at) * (y_at @ w_attn_out)
    return x + merged @ w_out


def setup_inputs(seed: int = 0) -> dict:
    key = jax.random.key(seed)
    ks = jax.random.split(key, 20)
    f32 = jnp.float32

    def nrm(k, shape, scale):
        return jax.random.normal(k, shape, f32) * scale

    hw3 = (HYENA_ORDER + 1) * HYENA_WIDTH
    return {
        "x": nrm(ks[0], (BATCH, SEQ, D_MODEL), 1.0),
        "norm_g": 1.0 + nrm(ks[1], (DEPTH, D_MODEL), 0.02),
        "w_in": nrm(ks[2], (DEPTH, D_MODEL, IN_WIDTH), D_MODEL ** -0.5),
        "conv_w": nrm(ks[3], (DEPTH, SHORT_CONV, hw3), SHORT_CONV ** -0.5),
        "conv_b": nrm(ks[4], (DEPTH, hw3), 0.02),
        "filt_w1": nrm(ks[5], (DEPTH, FILTER_EMB, FILTER_HIDDEN), FILTER_EMB ** -0.5),
        "filt_b1": nrm(ks[6], (DEPTH, FILTER_HIDDEN), 0.1),
        "filt_w2": nrm(ks[7], (DEPTH, FILTER_HIDDEN, FILTER_HIDDEN), FILTER_HIDDEN ** -0.5),
        "filt_b2": nrm(ks[8], (DEPTH, FILTER_HIDDEN), 0.1),
        "filt_w3": nrm(ks[9], (DEPTH, FILTER_HIDDEN, FILTER_HIDDEN), FILTER_HIDDEN ** -0.5),
        "filt_b3": nrm(ks[10], (DEPTH, FILTER_HIDDEN), 0.1),
        "filt_w4": nrm(ks[11], (DEPTH, FILTER_HIDDEN, HYENA_ORDER * HYENA_DIRS * HYENA_WIDTH), 0.05 * FILTER_HIDDEN ** -0.5),
        "filt_freq": FILTER_SIN_W + nrm(ks[12], (DEPTH, FILTER_HIDDEN), 0.02),
        "hyena_bias": nrm(ks[13], (DEPTH, HYENA_ORDER, HYENA_WIDTH), 1.0),
        "attn_sink": nrm(ks[14], (DEPTH, N_HEADS), 0.5),
        "w_hyena_out": nrm(ks[15], (DEPTH, HYENA_WIDTH, D_MODEL), HYENA_WIDTH ** -0.5),
        "w_attn_out": nrm(ks[16], (DEPTH, ATTN_WIDTH, D_MODEL), ATTN_WIDTH ** -0.5),
        "w_out": nrm(ks[17], (DEPTH, D_MODEL, D_MODEL), D_MODEL ** -0.5),
        "final_norm": 1.0 + nrm(ks[18], (D_MODEL,), 0.02),
    }


def reference(x, norm_g, w_in, conv_w, conv_b, filt_w1, filt_b1, filt_w2, filt_b2,
              filt_w3, filt_b3, filt_w4, filt_freq, hyena_bias, attn_sink,
              w_hyena_out, w_attn_out, w_out, final_norm):
    for l in range(DEPTH):
        x = hybrid_layer(x, norm_g[l], w_in[l], conv_w[l], conv_b[l],
                         filt_w1[l], filt_b1[l], filt_w2[l], filt_b2[l],
                         filt_w3[l], filt_b3[l], filt_w4[l], filt_freq[l],
                         hyena_bias[l], attn_sink[l],
                         w_hyena_out[l], w_attn_out[l], w_out[l])
    return rms_norm(x, final_norm)
```

```cpp
#include <hip/hip_runtime.h>
#include <hip/hip_cooperative_groups.h>
#include <cstdio>
#include <cstdint>
namespace cg = cooperative_groups;

#define LAS __attribute__((address_space(3)))
typedef unsigned short bf16_t;
typedef short bf16x8 __attribute__((ext_vector_type(8)));
typedef float f32x4 __attribute__((ext_vector_type(4)));
typedef unsigned u32x4 __attribute__((ext_vector_type(4)));
typedef unsigned u32x2 __attribute__((ext_vector_type(2)));

#ifndef PROBE_DUP
#define PROBE_DUP 0
#endif
#ifndef MK_MULTI
#define MK_MULTI 0
#endif

constexpr int SEQ = 2048, DM = 2048, NB = 8, MTOK = NB * SEQ, NIN = 10752, HW = 1024;
constexpr float EPS = 1e-6f;
constexpr size_t MiB = 1u << 20;
constexpr size_t WS_WIN = 0, WS_WH = 84 * MiB, WS_WA = 92 * MiB, WS_WO = 100 * MiB, WS_KR = 116 * MiB, WS_ROPE = 148 * MiB, WS_SSQ = 148 * MiB + 512 * 1024,
                 WS_BAR = 149 * MiB, WS_XB = 150 * MiB, WS_UT = 214 * MiB, WS_MG = 214 * MiB, WS_VT = 342 * MiB, WS_Q = 350 * MiB, WS_K = 382 * MiB, WS_ZA = 390 * MiB,
                 WS_GH = 422 * MiB, WS_GA = 486 * MiB, WS_YH = 550 * MiB, WS_YA = 582 * MiB, WS_SSQP = 614 * MiB, WS_END = 616 * MiB;
constexpr int LDS_BYTES = 149504, LDS_ST = 148544;
constexpr int NPHASE = 13;

struct Args {
    const float* x; const float* norm_g; const float* w_in; const float* conv_w; const float* conv_b;
    const float* fw1; const float* fb1; const float* fw2; const float* fb2; const float* fw3; const float* fb3; const float* fw4; const float* ffreq;
    const float* hbias; const float* sink; const float* w_hy; const float* w_at; const float* w_out; const float* fnorm;
    float* out; unsigned char* ws; int ph_lo, ph_hi;
};

__device__ __forceinline__ unsigned cvt_pk_bf16(float lo, float hi) { unsigned r; asm("v_cvt_pk_bf16_f32 %0, %1, %2" : "=v"(r) : "v"(lo), "v"(hi)); return r; }
__device__ __forceinline__ bf16_t f2bf(float v) { return (bf16_t)(cvt_pk_bf16(v, 0.f) & 0xffffu); }
__device__ __forceinline__ float bf2f(unsigned h) { return __uint_as_float(h << 16); }
__device__ __forceinline__ float bflo(unsigned w) { return __uint_as_float(w << 16); }
__device__ __forceinline__ float bfhi(unsigned w) { return __uint_as_float(w & 0xffff0000u); }
__device__ __forceinline__ int opaque_tid() { int t; asm volatile("v_mov_b32 %0, %1" : "=v"(t) : "v"(threadIdx.x)); return t; }
__device__ __forceinline__ float sin_rr(float x) { double r = (double)x * 0.15915494309189535; r -= rint(r); return __builtin_amdgcn_sinf((float)r); }
__device__ __forceinline__ float cos_rr(float x) { double r = (double)x * 0.15915494309189535; r -= rint(r); return __builtin_amdgcn_cosf((float)r); }
__device__ __forceinline__ float sigmoidf_(float x) { return __builtin_amdgcn_rcpf(1.f + __expf(-x)); }
__device__ __forceinline__ float siluf_(float x) { return x * sigmoidf_(x); }

namespace pg8 {
constexpr int BM = 256, BK = 64, HALF = 128, HTB = HALF * BK * 2, NXCD = 8, WGM = 8;
__host__ __device__ __forceinline__ int lds_byte(int r, int c) { const int st = (r >> 4) * 2 + (c >> 5), rr = r & 15, cc = c & 31, ob = rr * 64 + cc * 2; return st * 1024 + (ob ^ (((ob >> 9) & 1) << 5)); }
__host__ __device__ __forceinline__ void stage_rc(int b, int& R, int& C) { const int st = b / 1024, sb = b % 1024, swz = sb ^ (((sb >> 9) & 1) << 5); R = (st >> 1) * 16 + swz / 64; C = (st & 1) * 32 + (swz % 64) / 2; }
__host__ __device__ __forceinline__ int perm32(int rho) { const int n = rho >> 4, i = rho & 15; return 8 * (i >> 2) + 4 * n + (i & 3); }

struct Unit { const char* a; const char* b; int pm, pn; };

struct Sched {
    int mode, nN, K; const char* A; const char* B;
    __device__ __forceinline__ void init(int mode_, int N, int K_, const void* A_, const void* B_) { mode = mode_; nN = N / BM; K = K_; A = (const char*)A_; B = (const char*)B_; }
    __device__ __forceinline__ bool next(int i, Unit& u) const {
        const int nM = MTOK / BM, nwg = nM * nN, G = gridDim.x;
        const long L = (long)i * G + blockIdx.x; if (L >= nwg) return false;
        int wgid = (int)L; { const int q = nwg / NXCD, r = nwg % NXCD, xcd = wgid % NXCD, off = wgid / NXCD; wgid = (xcd < r ? xcd * (q + 1) : r * (q + 1) + (xcd - r) * q) + off; }
        const int nig = WGM * nN, gid = wgid / nig, fm = gid * WGM, gsz = (nM - fm) < WGM ? (nM - fm) : WGM;
        u.pm = fm + ((wgid % nig) % gsz); u.pn = (wgid % nig) / gsz;
        const bool tr = (mode == 0) && (u.pn < 16 || u.pn == 21);
        const size_t tstep = (size_t)BM * K * 2;
        const char* pa = A + (size_t)u.pm * tstep; const char* pb = B + (size_t)u.pn * tstep;
        u.a = tr ? pb : pa; u.b = tr ? pa : pb; return true;
    }
};

struct Epi {
    int mode, l;
    unsigned char* ws; const float* xold; float* xnew; int noss;

    __device__ __forceinline__ void operator()(const f32x4 (&acc)[2][2][4][2], const Unit& u) const {
        int tid_; asm volatile("v_mov_b32 %0, %1" : "=v"(tid_) : "v"(threadIdx.x));
        const int wid_ = tid_ >> 6, lane_ = tid_ & 63, wr = wid_ >> 2, wc = wid_ & 3, fr = lane_ & 15, fq = lane_ >> 4;
        const int rloc0 = wr * 64 + fr, cloc0 = wc * 32 + 8 * fq;
        if (mode == 0) {
            const float* ssq = (const float*)(ws + WS_SSQ) + (size_t)l * MTOK;
            if (u.pn < 16 || u.pn == 21) {
                bf16_t* base = (u.pn == 21) ? (bf16_t*)(ws + WS_VT) : ((bf16_t*)(ws + WS_UT) + (size_t)u.pn * 256 * MTOK);
                const bool act = (u.pn >= 12 && u.pn < 16);
                const int tok0 = u.pm * 256 + cloc0;
                f32x4 rr[2][2];
#pragma unroll
                for (int bj = 0; bj < 2; ++bj) { rr[bj][0] = *(const f32x4*)(ssq + tok0 + bj * HALF); rr[bj][1] = *(const f32x4*)(ssq + tok0 + bj * HALF + 4); }
                asm volatile("s_waitcnt vmcnt(0)" ::: "memory");
#pragma unroll
                for (int bj = 0; bj < 2; ++bj)
#pragma unroll
                    for (int h = 0; h < 2; ++h)
#pragma unroll
                        for (int e = 0; e < 4; ++e) rr[bj][h][e] = __builtin_amdgcn_rsqf(rr[bj][h][e] * (1.f / DM) + EPS);
#pragma unroll
                for (int bj = 0; bj < 2; ++bj)
#pragma unroll
                    for (int ai = 0; ai < 2; ++ai)
#pragma unroll
                        for (int m = 0; m < 4; ++m) {
                            f32x4 v0 = acc[ai][bj][m][0] * rr[bj][0], v1 = acc[ai][bj][m][1] * rr[bj][1];
                            if (act) {
#pragma unroll
                                for (int e = 0; e < 4; ++e) { v0[e] = siluf_(v0[e]); v1[e] = siluf_(v1[e]); } }
                            u32x4 w; w.x = cvt_pk_bf16(v0[0], v0[1]); w.y = cvt_pk_bf16(v0[2], v0[3]); w.z = cvt_pk_bf16(v1[0], v1[1]); w.w = cvt_pk_bf16(v1[2], v1[3]);
                            *(u32x4*)(base + (size_t)(rloc0 + ai * HALF + m * 16) * MTOK + tok0 + bj * HALF) = w;
                        }
            } else {
                const int pn = u.pn; bf16_t* base; int ld; int act;
                if (pn < 20) { base = (bf16_t*)(ws + WS_Q) + (pn - 16) * 256; ld = 1024; act = 1; }
                else if (pn == 20) { base = (bf16_t*)(ws + WS_K); ld = 256; act = 1; }
                else if (pn < 26) { base = (bf16_t*)(ws + WS_ZA) + (pn - 22) * 256; ld = 1024; act = 2; }
                else if (pn < 34) { base = (bf16_t*)(ws + WS_GH) + (pn - 26) * 256; ld = 2048; act = 3; }
                else { base = (bf16_t*)(ws + WS_GA) + (pn - 34) * 256; ld = 2048; act = 3; }
                const float* rope = (const float*)(ws + WS_ROPE);
                float rsv[8];
#pragma unroll
                for (int it = 0; it < 8; ++it) rsv[it] = ssq[u.pm * 256 + rloc0 + (it >> 2) * HALF + (it & 3) * 16];
                asm volatile("s_waitcnt vmcnt(0)" ::: "memory");
#pragma unroll
                for (int it = 0; it < 8; ++it) rsv[it] = __builtin_amdgcn_rsqf(rsv[it] * (1.f / DM) + EPS);
#pragma unroll
                for (int ai = 0; ai < 2; ++ai)
#pragma unroll
                    for (int m = 0; m < 4; ++m) {
                        const int row = u.pm * 256 + rloc0 + ai * HALF + m * 16;
                        const float rs = rsv[ai * 4 + m];
                        f32x4 c0 = {1.f, 1.f, 1.f, 1.f}, c1 = c0, sn0 = {0.f, 0.f, 0.f, 0.f}, sn1 = sn0;
                        if (act == 1 && wc == 0) { const float* rp = rope + (size_t)(row & (SEQ - 1)) * 32 + 8 * (fq & 1);
                            c0 = *(const f32x4*)rp; c1 = *(const f32x4*)(rp + 4); sn0 = *(const f32x4*)(rp + 16); sn1 = *(const f32x4*)(rp + 20);
                            asm volatile("s_waitcnt vmcnt(0)" ::: "memory");
                            if (fq < 2) { sn0 = -sn0; sn1 = -sn1; } }
#pragma unroll
                        for (int bj = 0; bj < 2; ++bj) {
                            f32x4 v0 = acc[ai][bj][m][0] * rs, v1 = acc[ai][bj][m][1] * rs;
                            if (act == 1) {
                                if (wc == 0) {
                                    f32x4 p0, p1;
#pragma unroll
                                    for (int e = 0; e < 4; ++e) { p0[e] = __shfl_xor(v0[e], 32); p1[e] = __shfl_xor(v1[e], 32); }
                                    v0 = v0 * c0 + p0 * sn0; v1 = v1 * c1 + p1 * sn1;
                                }
                            } else if (act == 2) {
#pragma unroll
                                for (int e = 0; e < 4; ++e) { v0[e] = siluf_(v0[e]); v1[e] = siluf_(v1[e]); }
                            } else if (act == 3) {
#pragma unroll
                                for (int e = 0; e < 4; ++e) { v0[e] = sigmoidf_(v0[e]); v1[e] = sigmoidf_(v1[e]); }
                            }
                            u32x4 w; w.x = cvt_pk_bf16(v0[0], v0[1]); w.y = cvt_pk_bf16(v0[2], v0[3]); w.z = cvt_pk_bf16(v1[0], v1[1]); w.w = cvt_pk_bf16(v1[2], v1[3]);
                            *(u32x4*)(base + (size_t)row * ld + cloc0 + bj * HALF) = w;
                        }
                        if (act == 1) asm volatile("" ::: "memory");
                    }
            }
        } else if (mode == 1 || mode == 2) {
            bf16_t* MG = (bf16_t*)(ws + WS_MG); const bf16_t* G = (const bf16_t*)(ws + (mode == 1 ? WS_GH : WS_GA));
            const size_t off0 = (size_t)(u.pm * 256 + rloc0) * DM + u.pn * 256 + cloc0;
#define EPI_ROWOFF(it) (off0 + (size_t)(((it) >> 2) * HALF + ((it) & 3) * 16) * DM)
#pragma unroll
            for (int ai = 0; ai < 2; ++ai) {
                u32x4 gb[4][2], pb[4][2];
#pragma unroll
                for (int m = 0; m < 4; ++m)
#pragma unroll
                    for (int bj = 0; bj < 2; ++bj) { gb[m][bj] = *(const u32x4*)(G + EPI_ROWOFF(ai * 4 + m) + bj * HALF); if (mode == 2) pb[m][bj] = *(const u32x4*)(MG + EPI_ROWOFF(ai * 4 + m) + bj * HALF); }
                asm volatile("s_waitcnt vmcnt(0)" ::: "memory");
#pragma unroll
                for (int m = 0; m < 4; ++m)
#pragma unroll
                    for (int bj = 0; bj < 2; ++bj) {
                        const u32x4 g = gb[m][bj];
                        f32x4 v0 = acc[ai][bj][m][0], v1 = acc[ai][bj][m][1];
                        v0[0] *= bflo(g.x); v0[1] *= bfhi(g.x); v0[2] *= bflo(g.y); v0[3] *= bfhi(g.y);
                        v1[0] *= bflo(g.z); v1[1] *= bfhi(g.z); v1[2] *= bflo(g.w); v1[3] *= bfhi(g.w);
                        if (mode == 2) { const u32x4 p = pb[m][bj];
                            v0[0] += bflo(p.x); v0[1] += bfhi(p.x); v0[2] += bflo(p.y); v0[3] += bfhi(p.y);
                            v1[0] += bflo(p.z); v1[1] += bfhi(p.z); v1[2] += bflo(p.w); v1[3] += bfhi(p.w); }
                        u32x4 w; w.x = cvt_pk_bf16(v0[0], v0[1]); w.y = cvt_pk_bf16(v0[2], v0[3]); w.z = cvt_pk_bf16(v1[0], v1[1]); w.w = cvt_pk_bf16(v1[2], v1[3]);
                        *(u32x4*)(MG + EPI_ROWOFF(ai * 4 + m) + bj * HALF) = w;
                    }
                asm volatile("s_waitcnt vmcnt(0)" ::: "memory");
            }
        } else {
            bf16_t* XB = (bf16_t*)(ws + WS_XB); float* ssqp = (float*)(ws + WS_SSQP);
            const size_t off0 = (size_t)(u.pm * 256 + rloc0) * DM + u.pn * 256 + cloc0;
#pragma unroll
            for (int ai = 0; ai < 2; ++ai) {
                f32x4 xb[4][2][2];
#pragma unroll
                for (int m = 0; m < 4; ++m)
#pragma unroll
                    for (int bj = 0; bj < 2; ++bj) { xb[m][bj][0] = *(const f32x4*)(xold + EPI_ROWOFF(ai * 4 + m) + bj * HALF); xb[m][bj][1] = *(const f32x4*)(xold + EPI_ROWOFF(ai * 4 + m) + bj * HALF + 4); }
                asm volatile("s_waitcnt vmcnt(0)" ::: "memory");
#pragma unroll
                for (int m = 0; m < 4; ++m) {
                    const int row = u.pm * 256 + rloc0 + ai * HALF + m * 16;
                    const size_t off = EPI_ROWOFF(ai * 4 + m);
                    float ss = 0.f;
#pragma unroll
                    for (int bj = 0; bj < 2; ++bj) {
                        const f32x4 v0 = acc[ai][bj][m][0] + xb[m][bj][0], v1 = acc[ai][bj][m][1] + xb[m][bj][1];
                        *(f32x4*)(xnew + off + bj * HALF) = v0; *(f32x4*)(xnew + off + bj * HALF + 4) = v1;
                        u32x4 w; w.x = cvt_pk_bf16(v0[0], v0[1]); w.y = cvt_pk_bf16(v0[2], v0[3]); w.z = cvt_pk_bf16(v1[0], v1[1]); w.w = cvt_pk_bf16(v1[2], v1[3]);
                        if (l == 0) *(u32x4*)(XB + off + bj * HALF) = w;
                        ss += (v0[0] * v0[0] + v0[1] * v0[1]) + (v0[2] * v0[2] + v0[3] * v0[3]) + (v1[0] * v1[0] + v1[1] * v1[1]) + (v1[2] * v1[2] + v1[3] * v1[3]);
                    }
                    ss += __shfl_xor(ss, 16); ss += __shfl_xor(ss, 32);
                    if (fq == 0) ssqp[(size_t)row * 32 + u.pn * 4 + wc] = ss;
                }
                asm volatile("s_waitcnt vmcnt(0)" ::: "memory");
            }
#undef EPI_ROWOFF
        }
        asm volatile("s_waitcnt vmcnt(0)" ::: "memory");
    }
};

__device__ __forceinline__ void gemm_phase(LAS unsigned char* lds, const Sched& S, const Epi& E) {
    const int K = S.K;
    const int tid = opaque_tid(), wid = __builtin_amdgcn_readfirstlane(tid >> 6), lane = tid & 63, wr = wid >> 2, wc = wid & 3, fr = lane & 15, fq = lane >> 4;
    const int nt = K / BK;
    unsigned voffA[2], voffB[2];
#pragma unroll
    for (int i = 0; i < 2; ++i) { int R, C; stage_rc(tid * 16 + i * 8192, R, C); const int Rb = (R & ~31) + perm32(R & 31);
        voffA[i] = (unsigned)(R * K + C) * 2u; voffB[i] = (unsigned)(Rb * K + C) * 2u; }
    const size_t kstep = (size_t)(BK * 2);
    const size_t hstep = (size_t)HALF * K * 2;
    const unsigned ldsw = (unsigned)wid * 1024u;
    const int aoff = lds_byte(wr * 64 + fr, fq * 8), boff = lds_byte(wc * 32 + fr, fq * 8);
#define PG8_SA(b, h) (((b) * 2 + (h)) * HTB)
#define PG8_SB(b, h) ((4 + (b) * 2 + (h)) * HTB)
#define PG8_STAGE(bufoff, gbase, voff) do { _Pragma("unroll") for (int _i = 0; _i < 2; ++_i) \
        __builtin_amdgcn_global_load_lds((const unsigned*)((const char*)(gbase) + (voff)[_i]), (LAS unsigned*)(lds + (bufoff) + ldsw + _i * 8192), 16, 0, 0); } while (0)
#define PG8_LDA(dst, b, h) do { _Pragma("unroll") for (int m = 0; m < 4; ++m) _Pragma("unroll") for (int k = 0; k < 2; ++k) dst[m][k] = *(const LAS bf16x8*)(lds + PG8_SA(b, h) + aoff + m * 2048 + k * 1024); } while (0)
#define PG8_LDB(dst, b, h) do { _Pragma("unroll") for (int n = 0; n < 2; ++n) _Pragma("unroll") for (int k = 0; k < 2; ++k) dst[n][k] = *(const LAS bf16x8*)(lds + PG8_SB(b, h) + boff + n * 2048 + k * 1024); } while (0)
#define PG8_MMA(ai, bj, At, Bt) do { __builtin_amdgcn_s_setprio(1); _Pragma("unroll") for (int m = 0; m < 4; ++m) _Pragma("unroll") for (int n = 0; n < 2; ++n) _Pragma("unroll") for (int k = 0; k < 2; ++k) \
        acc[ai][bj][m][n] = __builtin_amdgcn_mfma_f32_16x16x32_bf16(Bt[n][k], At[m][k], acc[ai][bj][m][n], 0, 0, 0); __builtin_amdgcn_s_setprio(0); } while (0)
#define PG8_WAIT_V(n) asm volatile("s_waitcnt vmcnt(" #n ")" ::: "memory")
#define PG8_WAIT_L(n) asm volatile("s_waitcnt lgkmcnt(" #n ")" ::: "memory")
#define PG8_BAR __builtin_amdgcn_s_barrier()
#define PG8_SCHED __builtin_amdgcn_sched_barrier(0)
    Unit cur, nxt; int ui = 0;
    if (!S.next(0, cur)) return;
    f32x4 acc[2][2][4][2];
#pragma unroll
    for (int a = 0; a < 2; ++a)
#pragma unroll
        for (int b = 0; b < 2; ++b)
#pragma unroll
            for (int m = 0; m < 4; ++m)
#pragma unroll
                for (int n = 0; n < 2; ++n) acc[a][b][m][n] = (f32x4){0.f, 0.f, 0.f, 0.f};
    bf16x8 At[4][2], B0[2][2], B1[2][2];
    const char* cA = cur.a; const char* cB = cur.b;
    PG8_STAGE(PG8_SB(0, 0), cB, voffB); PG8_STAGE(PG8_SB(0, 1), cB + hstep, voffB); PG8_STAGE(PG8_SA(0, 0), cA, voffA); PG8_STAGE(PG8_SA(0, 1), cA + hstep, voffA);
    if (wr == 1) PG8_BAR;
    PG8_WAIT_V(2); PG8_BAR;
    PG8_STAGE(PG8_SB(1, 0), cB + kstep, voffB); PG8_STAGE(PG8_SA(1, 0), cA + kstep, voffA); PG8_STAGE(PG8_SB(1, 1), cB + hstep + kstep, voffB);
    PG8_WAIT_V(6); PG8_BAR;
    for (;;) {
        const bool has_next = S.next(ui + 1, nxt);
        const char* nA = has_next ? nxt.a : cA; const char* nB = has_next ? nxt.b : cB;
        for (int t = 0; t < nt; t += 2) {
            const bool last = (t == nt - 2);
            const char* a1 = cA + (size_t)(t + 1) * kstep;
            const char* a2 = last ? nA : cA + (size_t)(t + 2) * kstep; const char* b2 = last ? nB : cB + (size_t)(t + 2) * kstep;
            const char* a3 = a2 + kstep; const char* b3 = b2 + kstep;
            PG8_LDB(B0, 0, 0); PG8_LDB(B1, 0, 1); PG8_SCHED; PG8_LDA(At, 0, 0); PG8_STAGE(PG8_SA(1, 1), a1 + hstep, voffA);
            PG8_WAIT_V(8); PG8_WAIT_L(0); PG8_BAR; PG8_MMA(0, 0, At, B0); PG8_MMA(0, 1, At, B1); PG8_BAR; PG8_SCHED;
            PG8_LDA(At, 0, 1); PG8_STAGE(PG8_SB(0, 0), b2, voffB); PG8_STAGE(PG8_SB(0, 1), b2 + hstep, voffB); PG8_STAGE(PG8_SA(0, 0), a2, voffA);
            PG8_WAIT_V(8); PG8_WAIT_L(0); PG8_BAR; PG8_MMA(1, 0, At, B0); PG8_MMA(1, 1, At, B1); PG8_BAR; PG8_SCHED;
            PG8_LDB(B0, 1, 0); PG8_LDB(B1, 1, 1); PG8_SCHED; PG8_LDA(At, 1, 0); PG8_STAGE(PG8_SA(0, 1), a2 + hstep, voffA);
            PG8_WAIT_V(8); PG8_WAIT_L(0); PG8_BAR; PG8_MMA(0, 0, At, B0); PG8_MMA(0, 1, At, B1); PG8_BAR; PG8_SCHED;
            PG8_LDA(At, 1, 1); PG8_STAGE(PG8_SB(1, 0), b3, voffB); PG8_STAGE(PG8_SB(1, 1), b3 + hstep, voffB); PG8_STAGE(PG8_SA(1, 0), a3, voffA);
            PG8_WAIT_V(8); PG8_WAIT_L(0); PG8_BAR; PG8_MMA(1, 0, At, B0); PG8_MMA(1, 1, At, B1); PG8_BAR; PG8_SCHED;
        }
        if (wr == 0) PG8_BAR;
        E(acc, cur);
        if (!has_next) break;
#pragma unroll
        for (int a = 0; a < 2; ++a)
#pragma unroll
            for (int b = 0; b < 2; ++b)
#pragma unroll
                for (int m = 0; m < 4; ++m)
#pragma unroll
                    for (int n = 0; n < 2; ++n) acc[a][b][m][n] = (f32x4){0.f, 0.f, 0.f, 0.f};
        cur = nxt; cA = nA; cB = nB; ++ui;
        if (wr == 1) PG8_BAR;
    }
    PG8_WAIT_V(0);
    PG8_BAR;
#undef PG8_SA
#undef PG8_SB
#undef PG8_STAGE
#undef PG8_LDA
#undef PG8_LDB
#undef PG8_MMA
#undef PG8_WAIT_V
#undef PG8_WAIT_L
#undef PG8_BAR
#undef PG8_SCHED
}
}

__device__ void transpose_cvt(LAS unsigned char* lds, const float* __restrict__ src, bf16_t* __restrict__ dst, int R, int C, const float* __restrict__ scale, int G, int bid) {
    LAS float* T = (LAS float*)lds;
    const int tid = opaque_tid(), lane = tid & 63, wid = tid >> 6;
    const int tc = C / 256, nt = (R / 64) * tc;
    for (int t = bid; t < nt; t += G) {
        const int r0 = (t / tc) * 64, c0 = (t % tc) * 256;
        __syncthreads();
#pragma unroll
        for (int i = 0; i < 8; ++i) { const int row = wid + 8 * i; const float sc = scale ? scale[r0 + row] : 1.f;
            const float* sp = src + (size_t)(r0 + row) * C + c0 + lane;
#pragma unroll
            for (int j = 0; j < 4; ++j) T[row * 257 + j * 64 + lane] = sp[j * 64] * sc; }
        __syncthreads();
        const int rp = lane & 31, cs = lane >> 5;
#pragma unroll
        for (int i = 0; i < 16; ++i) { const int cc = wid * 32 + i * 2 + cs;
            const unsigned w = cvt_pk_bf16(T[(2 * rp) * 257 + cc], T[(2 * rp + 1) * 257 + cc]);
            *(unsigned*)(dst + (size_t)(c0 + cc) * R + r0 + 2 * rp) = w; }
    }
}

__device__ void filter_gen(LAS unsigned char* lds, const Args& a, int G, int bid) {
    LAS float* F = (LAS float*)lds;
    LAS float* HA = F + 64 * 33;
    LAS float* HB = HA + 64 * 64;
    const int tid = opaque_tid(), lane = tid & 63, wid = __builtin_amdgcn_readfirstlane(tid >> 6);
    bf16_t* KR = (bf16_t*)(a.ws + WS_KR);
    const float MIN_DECAY = -15.350567286626973f, MAX_DECAY = -3.0701134573253945f;
    for (int it = bid; it < 256; it += G) {
        const int l = it >> 7, tt = (it >> 2) & 31, nc = it & 3;
        const int tlo = tt * 64 + ((nc & 1) ? 0 : 1);
        const float* w1 = a.fw1 + l * 33 * 64; const float* b1 = a.fb1 + l * 64; const float* w2 = a.fw2 + l * 64 * 64; const float* b2 = a.fb2 + l * 64;
        const float* w3 = a.fw3 + l * 64 * 64; const float* b3 = a.fb3 + l * 64; const float* w4 = a.fw4 + (size_t)l * 64 * 4096; const float* fr_ = a.ffreq + l * 64;
        __syncthreads();
        for (int idx = tid; idx < 64 * 33; idx += 512) {
            const int t = idx / 33, j = idx % 33; const int tg = tlo + t; float v;
            if (j == 0) v = (float)tg / (float)(SEQ - 1);
            else { const int bi = (j - 1) & 15; const float band = 1e-4f + (float)bi * ((15.f - 1e-4f) / 15.f);
                const float ang = ((float)(2.0 * 3.14159265358979323846 / SEQ) * (float)tg) * band; v = (j <= 16) ? cos_rr(ang) : -sin_rr(ang); }
            F[idx] = v;
        }
        __syncthreads();
        const int t = tid >> 3, j0 = (tid & 7) * 8;
        {   float s[8];
#pragma unroll
            for (int e = 0; e < 8; ++e) s[e] = b1[j0 + e];
#pragma unroll 11
            for (int k = 0; k < 33; ++k) { const float f = F[t * 33 + k];
#pragma unroll
                for (int e = 0; e < 8; ++e) s[e] += f * w1[k * 64 + j0 + e]; }
#pragma unroll
            for (int e = 0; e < 8; ++e) HA[t * 64 + j0 + e] = sin_rr(fr_[j0 + e] * s[e]);
        }
        __syncthreads();
        {   float s[8];
#pragma unroll
            for (int e = 0; e < 8; ++e) s[e] = b2[j0 + e];
#pragma unroll 16
            for (int k = 0; k < 64; ++k) { const float f = HA[t * 64 + k];
#pragma unroll
                for (int e = 0; e < 8; ++e) s[e] += f * w2[k * 64 + j0 + e]; }
#pragma unroll
            for (int e = 0; e < 8; ++e) HB[t * 64 + j0 + e] = sin_rr(fr_[j0 + e] * s[e]);
        }
        __syncthreads();
        {   float s[8];
#pragma unroll
            for (int e = 0; e < 8; ++e) s[e] = b3[j0 + e];
#pragma unroll 16
            for (int k = 0; k < 64; ++k) { const float f = HB[t * 64 + k];
#pragma unroll
                for (int e = 0; e < 8; ++e) s[e] += f * w3[k * 64 + j0 + e]; }
#pragma unroll
            for (int e = 0; e < 8; ++e) HA[t * 64 + j0 + e] = sin_rr(fr_[j0 + e] * s[e]);
        }
        __syncthreads();
        {
            const int fr = lane & 15, fq = lane >> 4;
            bf16x8 Ahi[4][2], Alo[4][2];
#pragma unroll
            for (int t4 = 0; t4 < 4; ++t4)
#pragma unroll
                for (int ks = 0; ks < 2; ++ks) {
                    const LAS float* hp = HA + (16 * t4 + fr) * 64 + 32 * ks + 8 * fq;
                    const f32x4 h0 = *(const LAS f32x4*)hp, h1 = *(const LAS f32x4*)(hp + 4);
                    u32x4 hi, lo;
                    hi.x = cvt_pk_bf16(h0[0], h0[1]); hi.y = cvt_pk_bf16(h0[2], h0[3]); hi.z = cvt_pk_bf16(h1[0], h1[1]); hi.w = cvt_pk_bf16(h1[2], h1[3]);
                    lo.x = cvt_pk_bf16(h0[0] - bflo(hi.x), h0[1] - bfhi(hi.x)); lo.y = cvt_pk_bf16(h0[2] - bflo(hi.y), h0[3] - bfhi(hi.y));
                    lo.z = cvt_pk_bf16(h1[0] - bflo(hi.z), h1[1] - bfhi(hi.z)); lo.w = cvt_pk_bf16(h1[2] - bflo(hi.w), h1[3] - bfhi(hi.w));
                    Ahi[t4][ks] = __builtin_bit_cast(bf16x8, hi); Alo[t4][ks] = __builtin_bit_cast(bf16x8, lo);
                }
            const int nw0 = nc * 1024 + wid * 128;
            const int o = nw0 >> 11, dir = (nw0 >> 10) & 1;
#pragma unroll 2
            for (int nt = 0; nt < 8; ++nt) {
                const int n = nw0 + 16 * nt + fr, c = n & 1023;
                bf16x8 Bhi[2], Blo[2];
#pragma unroll
                for (int ks = 0; ks < 2; ++ks) {
                    float wv[8];
#pragma unroll
                    for (int j = 0; j < 8; ++j) wv[j] = w4[(size_t)(32 * ks + 8 * fq + j) * 4096 + n];
                    u32x4 hi, lo;
                    hi.x = cvt_pk_bf16(wv[0], wv[1]); hi.y = cvt_pk_bf16(wv[2], wv[3]); hi.z = cvt_pk_bf16(wv[4], wv[5]); hi.w = cvt_pk_bf16(wv[6], wv[7]);
                    lo.x = cvt_pk_bf16(wv[0] - bflo(hi.x), wv[1] - bfhi(hi.x)); lo.y = cvt_pk_bf16(wv[2] - bflo(hi.y), wv[3] - bfhi(hi.y));
                    lo.z = cvt_pk_bf16(wv[4] - bflo(hi.z), wv[5] - bfhi(hi.z)); lo.w = cvt_pk_bf16(wv[6] - bflo(hi.w), wv[7] - bfhi(hi.w));
                    Bhi[ks] = __builtin_bit_cast(bf16x8, hi); Blo[ks] = __builtin_bit_cast(bf16x8, lo);
                }
                const float ndl2 = -fabsf(MIN_DECAY + (float)c * ((MAX_DECAY - MIN_DECAY) / 1023.f)) * (1.4426950408889634f / (float)(SEQ - 1));
                bf16_t* row = KR + ((size_t)((l * 2 + o) * 1024 + c)) * 4096;
#pragma unroll
                for (int t4 = 0; t4 < 4; ++t4) {
                    f32x4 d = {0.f, 0.f, 0.f, 0.f};
#pragma unroll
                    for (int ks = 0; ks < 2; ++ks) {
                        d = __builtin_amdgcn_mfma_f32_16x16x32_bf16(Alo[t4][ks], Bhi[ks], d, 0, 0, 0);
                        d = __builtin_amdgcn_mfma_f32_16x16x32_bf16(Ahi[t4][ks], Blo[ks], d, 0, 0, 0);
                        d = __builtin_amdgcn_mfma_f32_16x16x32_bf16(Ahi[t4][ks], Bhi[ks], d, 0, 0, 0);
                    }
                    const int t2 = 16 * t4 + 4 * fq;
                    float v[4];
#pragma unroll
                    for (int j = 0; j < 4; ++j) { const int tg = tlo + t2 + j; v[j] = d[j] * __builtin_amdgcn_exp2f((float)tg * ndl2); if (tg == SEQ) v[j] = 0.f; }
                    if (dir == 1 && tt == 0 && t4 == 0 && fq == 0) {
                        float sf = 0.f;
                        for (int k = 0; k < 64; ++k) sf += HA[k] * w4[(size_t)k * 4096 + n - 1024];
                        v[0] = sf; }
                    if (dir) *(u32x2*)(row + 2048 + tt * 64 + t2) = (u32x2){cvt_pk_bf16(v[0], v[1]), cvt_pk_bf16(v[2], v[3])};
                    else     *(u32x2*)(row + 1984 - tt * 64 + 60 - t2) = (u32x2){cvt_pk_bf16(v[3], v[2]), cvt_pk_bf16(v[1], v[0])};
                }
            }
        }
    }
}

__device__ void prologue(LAS unsigned char* lds, const Args& a, int G, int bid) {
    unsigned char* ws = a.ws;
    for (int l = 0; l < 2; ++l) {
        transpose_cvt(lds, a.w_in + (size_t)l * DM * NIN, (bf16_t*)(ws + WS_WIN) + (size_t)l * NIN * DM, DM, NIN, a.norm_g + l * DM, G, bid);
        transpose_cvt(lds, a.w_hy + (size_t)l * HW * DM, (bf16_t*)(ws + WS_WH) + (size_t)l * DM * HW, HW, DM, nullptr, G, bid);
        transpose_cvt(lds, a.w_at + (size_t)l * HW * DM, (bf16_t*)(ws + WS_WA) + (size_t)l * DM * HW, HW, DM, nullptr, G, bid);
        transpose_cvt(lds, a.w_out + (size_t)l * DM * DM, (bf16_t*)(ws + WS_WO) + (size_t)l * DM * DM, DM, DM, nullptr, G, bid);
    }
    filter_gen(lds, a, G, bid);
    {
        float* rope = (float*)(ws + WS_ROPE);
        for (int idx = bid * 512 + opaque_tid(); idx < SEQ * 16; idx += G * 512) {
            const int pos = idx >> 4, i = idx & 15;
            const float inv = exp2f(-(float)(2 * i) * (18.931568569324174f / 32.0f)), ang = (float)pos * inv;
            rope[pos * 32 + i] = cos_rr(ang); rope[pos * 32 + 16 + i] = sin_rr(ang);
        }
    }
    {
        float* ssq = (float*)(ws + WS_SSQ); bf16_t* XB = (bf16_t*)(ws + WS_XB);
        const int tid = opaque_tid(), lane = tid & 63, wid = tid >> 6;
        for (int row = bid * 8 + wid; row < MTOK; row += G * 8) {
            const float* xr = a.x + (size_t)row * DM; float ss = 0.f;
#pragma unroll
            for (int i = 0; i < 4; ++i) {
                const f32x4 v0 = *(const f32x4*)(xr + i * 512 + lane * 8), v1 = *(const f32x4*)(xr + i * 512 + lane * 8 + 4);
                ss += (v0[0] * v0[0] + v0[1] * v0[1]) + (v0[2] * v0[2] + v0[3] * v0[3]) + (v1[0] * v1[0] + v1[1] * v1[1]) + (v1[2] * v1[2] + v1[3] * v1[3]);
                u32x4 w; w.x = cvt_pk_bf16(v0[0], v0[1]); w.y = cvt_pk_bf16(v0[2], v0[3]); w.z = cvt_pk_bf16(v1[0], v1[1]); w.w = cvt_pk_bf16(v1[2], v1[3]);
                *(u32x4*)(XB + (size_t)row * DM + i * 512 + lane * 8) = w;
            }
#pragma unroll
            for (int o = 32; o >= 1; o >>= 1) ss += __shfl_xor(ss, o);
            if (lane == 0) { ssq[row] = ss; ssq[MTOK + row] = 0.f; ssq[2 * MTOK + row] = 0.f; }
        }
    }
}

__device__ void ssq_reduce(const Args& a, int bid) {
    const float* ssqp = (const float*)(a.ws + WS_SSQP); float* ssq = (float*)(a.ws + WS_SSQ) + MTOK;
    const int tid = opaque_tid();
    for (int row = bid * 64 + tid; row < MTOK && tid < 64; row += gridDim.x * 64) {
        float s0 = 0.f;
#pragma unroll
        for (int j = 0; j < 8; ++j) { const f32x4 p0 = *(const f32x4*)(ssqp + (size_t)row * 32 + j * 4); s0 += (p0[0] + p0[1]) + (p0[2] + p0[3]); }
        ssq[row] = s0;
    }
}

__device__ void final_norm(const Args& a, int G, int bid, float* dstp) {
    const float* ssqp = (const float*)(a.ws + WS_SSQP);
    const int tid = opaque_tid(), lane = tid & 63, wid = tid >> 6;
    for (int row = (bid * 8 + wid) * 2; row < MTOK; row += G * 16) {
        float s0 = 0.f, s1 = 0.f;
#pragma unroll
        for (int j = 0; j < 8; ++j) { const f32x4 p0 = *(const f32x4*)(ssqp + (size_t)row * 32 + j * 4), p1 = *(const f32x4*)(ssqp + (size_t)(row + 1) * 32 + j * 4);
            s0 += (p0[0] + p0[1]) + (p0[2] + p0[3]); s1 += (p1[0] + p1[1]) + (p1[2] + p1[3]); }
        const float rs0 = __builtin_amdgcn_rsqf(s0 * (1.f / DM) + EPS), rs1 = __builtin_amdgcn_rsqf(s1 * (1.f / DM) + EPS);
        const float* xr = a.out + (size_t)row * DM; float* xw = dstp + (size_t)row * DM;
        f32x4 v[16];
#pragma unroll
        for (int i = 0; i < 16; ++i) v[i] = *(const f32x4*)(xr + i * 256 + lane * 4);
#pragma unroll
        for (int i = 0; i < 16; ++i) { const f32x4 g = *(const f32x4*)(a.fnorm + (i & 7) * 256 + lane * 4);
            *(f32x4*)(xw + i * 256 + lane * 4) = v[i] * (i < 8 ? rs0 : rs1) * g; }
    }
}

constexpr int HY_PITCH = 4112, HY_UB = 0, HY_KR0 = 33024, HY_KRSZ = 8448, HY_YB = 50176;
__device__ __forceinline__ bf16x8 hy_ldA(const LAS unsigned char* kr, int byteoff) {
    const LAS unsigned* p = (const LAS unsigned*)(kr + byteoff);
    u32x4 v; v.x = p[0]; v.y = p[1]; v.z = p[2]; v.w = p[3];
    return __builtin_bit_cast(bf16x8, v);
}
__device__ __forceinline__ bf16x8 hy_ldB(const LAS unsigned char* p, unsigned sh) {
    const u32x4 w = *(const LAS u32x4*)p; const unsigned w4 = *(const LAS unsigned*)(p + 16);
    u32x4 o; o.x = __builtin_amdgcn_alignbit(w.y, w.x, sh); o.y = __builtin_amdgcn_alignbit(w.z, w.y, sh); o.z = __builtin_amdgcn_alignbit(w.w, w.z, sh); o.w = __builtin_amdgcn_alignbit(w4, w.w, sh);
    return __builtin_bit_cast(bf16x8, o);
}
__device__ __forceinline__ void hy_conv(f32x4 (&acc)[8], const LAS unsigned char* kr, const LAS unsigned char* ubrow, int abase, int mi0, unsigned sh) {
#pragma unroll
    for (int q = 0; q < 8; ++q) acc[q] = (f32x4){0.f, 0.f, 0.f, 0.f};
    bf16x8 A[8];
#pragma unroll
    for (int q = 0; q < 8; ++q) A[q] = hy_ldA(kr, abase - 64 * (mi0 + q));
    bf16x8 B = hy_ldB(ubrow, sh);
    for (int k = 0; k < 8; ++k) {
#pragma unroll
        for (int u = 0; u < 8; ++u) {
            const int si = 8 * k + u;
            const bf16x8 Bn = hy_ldB(ubrow + ((si + 1) & 63) * 64, sh);
            const bf16x8 An = hy_ldA(kr, abase - 64 * (mi0 - si - 1));
            __builtin_amdgcn_s_setprio(1);
#pragma unroll
            for (int q = 0; q < 8; ++q) acc[q] = __builtin_amdgcn_mfma_f32_16x16x32_bf16(A[(q - u) & 7], B, acc[q], 0, 0, 0);
            __builtin_amdgcn_s_setprio(0);
            A[(7 - u) & 7] = An; B = Bn;
        }
    }
}
__device__ __forceinline__ f32x4 hy_sc4(const u32x4 ch, float prev, float next, int r, float w0, float w1, float w2, float bs) {
    const float x0 = bflo(ch.x), x1 = bfhi(ch.x), x2 = bflo(ch.y), x3 = bfhi(ch.y), x4 = bflo(ch.z), x5 = bfhi(ch.z), x6 = bflo(ch.w), x7 = bfhi(ch.w);
    f32x4 o;
    o[0] = bs + w0 * (r ? x0 : prev) + w1 * (r ? x1 : x0) + w2 * (r ? x2 : x1);
    o[1] = bs + w0 * (r ? x2 : x1) + w1 * (r ? x3 : x2) + w2 * (r ? x4 : x3);
    o[2] = bs + w0 * (r ? x4 : x3) + w1 * (r ? x5 : x4) + w2 * (r ? x6 : x5);
    o[3] = bs + w0 * (r ? x6 : x5) + w1 * (r ? x7 : x6) + w2 * (r ? next : x7);
    return o;
}
__device__ __forceinline__ f32x4 hy_load_sc4(const bf16_t* rowp, int t0, int r, float w0, float w1, float w2, float bs) {
    const u32x4 ch = *(const u32x4*)(rowp + t0);
    const unsigned pv = rowp[t0 > 0 ? t0 - 1 : 0], nv = rowp[t0 + 8 < SEQ ? t0 + 8 : SEQ - 1];
    const float prev = t0 > 0 ? bf2f(pv) : 0.f, next = (t0 + 8 < SEQ) ? bf2f(nv) : 0.f;
    return hy_sc4(ch, prev, next, r, w0, w1, w2, bs);
}

__device__ void hyena_item(LAS unsigned char* lds, const Args& a, int l, int c4) {
    const bf16_t* UT = (const bf16_t*)(a.ws + WS_UT);
    const bf16_t* KRg = (const bf16_t*)(a.ws + WS_KR);
    bf16_t* YH = (bf16_t*)(a.ws + WS_YH);
    LAS unsigned char* ub = lds + HY_UB;
    const float* cw = a.conv_w + (size_t)l * 3 * 3072; const float* cb = a.conv_b + (size_t)l * 3072;
#pragma unroll 1
    for (int ch = 0; ch < 4; ++ch) {
    const int c = c4 * 4 + ch;
    const int tid = opaque_tid(), lane = tid & 63, wid = __builtin_amdgcn_readfirstlane(tid >> 6), fr = lane & 15, fq = lane >> 4;
    __syncthreads();
#pragma unroll
    for (int o = 0; o < 2; ++o)
        *(LAS u32x4*)(lds + HY_KR0 + o * HY_KRSZ + tid * 16) = *(const u32x4*)(KRg + ((size_t)((l * 2 + o) * 1024 + c)) * 4096 + tid * 8);
    {   const float w0 = cw[c], w1 = cw[3072 + c], w2 = cw[2 * 3072 + c], bs = cb[c];
        const bf16_t* rowp = UT + (size_t)c * MTOK;
#pragma unroll
        for (int i = 0; i < 4; ++i) {
            const int q = tid + 512 * i, b = q >> 8, t0 = (q & 255) * 8;
            const bf16_t* rp = rowp + b * SEQ;
            const f32x4 e0 = hy_load_sc4(rp, t0, 0, w0, w1, w2, bs), e1 = hy_load_sc4(rp, t0, 1, w0, w1, w2, bs);
            u32x4 w; w.x = cvt_pk_bf16(e0[0], e1[0]); w.y = cvt_pk_bf16(e0[1], e1[1]); w.z = cvt_pk_bf16(e0[2], e1[2]); w.w = cvt_pk_bf16(e0[3], e1[3]);
            *(LAS u32x4*)(ub + b * HY_PITCH + t0 * 2) = w;
            if (t0 == SEQ - 8) *(LAS u32x4*)(ub + b * HY_PITCH + SEQ * 2) = (u32x4){0u, 0u, 0u, 0u};
        }
    }
    __syncthreads();
    const int b = fr >> 1, r = fr & 1, mi0 = wid * 8;
    const unsigned sh = 16u * (unsigned)r;
    const int abase = 4096 - 4 * fr + 16 * fq;
    const LAS unsigned char* ubrow = ub + b * HY_PITCH + fq * 16;
    f32x4 acc[8];
    u32x4 pc[8]; unsigned pp[8], pn[8];
    {   const bf16_t* rp = UT + (size_t)(1024 + c) * MTOK + b * SEQ;
#pragma unroll
        for (int q = 0; q < 8; ++q) { const int t0 = 32 * (mi0 + q) + 8 * fq;
            pc[q] = *(const u32x4*)(rp + t0); pp[q] = rp[t0 > 0 ? t0 - 1 : 0]; pn[q] = rp[t0 + 8 < SEQ ? t0 + 8 : SEQ - 1]; }
    }
    hy_conv(acc, lds + HY_KR0, ubrow, abase, mi0, sh);
    const float u0 = bf2f(*(const LAS bf16_t*)(ub + b * HY_PITCH));
    __syncthreads();
    {   const float bias0 = a.hbias[(size_t)(l * 2 + 0) * 1024 + c];
        const float w0 = cw[1024 + c], w1 = cw[3072 + 1024 + c], w2 = cw[2 * 3072 + 1024 + c], bs = cb[1024 + c];
#pragma unroll
        for (int q = 0; q < 8; ++q) {
            const int t0 = 32 * (mi0 + q) + 8 * fq;
            const f32x4 hx1 = hy_sc4(pc[q], t0 > 0 ? bf2f(pp[q]) : 0.f, (t0 + 8 < SEQ) ? bf2f(pn[q]) : 0.f, r, w0, w1, w2, bs);
#pragma unroll
            for (int j = 0; j < 4; ++j) {
                const int t = t0 + 2 * j + r;
                const float hv = bf2f(*(const LAS bf16_t*)(ub + b * HY_PITCH + t * 2));
                float v = acc[q][j] + bias0 * hv;
                if (r) v += bf2f(*(const LAS bf16_t*)(lds + HY_KR0 + (2048 - t) * 2)) * u0;
                acc[q][j] = hx1[j] * v;
            }
        }
    }
    __syncthreads();
#pragma unroll
    for (int q = 0; q < 8; ++q)
#pragma unroll
        for (int j = 0; j < 4; ++j) { const int t = 32 * (mi0 + q) + 8 * fq + 2 * j + r; *(LAS bf16_t*)(ub + b * HY_PITCH + t * 2) = f2bf(acc[q][j]); }
    u32x2 zq[8];
    {   const bf16_t* rp = UT + (size_t)(2048 + c) * MTOK + b * SEQ;
        const bf16_t* zp = UT + (size_t)(3072 + c) * MTOK + b * SEQ;
#pragma unroll
        for (int q = 0; q < 8; ++q) { const int t0 = 32 * (mi0 + q) + 8 * fq;
            pc[q] = *(const u32x4*)(rp + t0); pp[q] = rp[t0 > 0 ? t0 - 1 : 0]; pn[q] = rp[t0 + 8 < SEQ ? t0 + 8 : SEQ - 1];
            const u32x4 zc = *(const u32x4*)(zp + t0);
            zq[q].x = r ? ((zc.x >> 16) | (zc.y & 0xffff0000u)) : ((zc.x & 0xffffu) | (zc.y << 16));
            zq[q].y = r ? ((zc.z >> 16) | (zc.w & 0xffff0000u)) : ((zc.z & 0xffffu) | (zc.w << 16)); }
    }
    __syncthreads();
    if (PROBE_DUP == 10) { hy_conv(acc, lds + HY_KR0 + HY_KRSZ, ubrow, abase, mi0, sh); asm volatile("" :: "v"(acc[0]), "v"(acc[1]), "v"(acc[2]), "v"(acc[3]), "v"(acc[4]), "v"(acc[5]), "v"(acc[6]), "v"(acc[7])); }
    hy_conv(acc, lds + HY_KR0 + HY_KRSZ, ubrow, abase, mi0, sh);
    {   const float z0 = bf2f(*(const LAS bf16_t*)(ub + b * HY_PITCH));
        const float bias1 = a.hbias[(size_t)(l * 2 + 1) * 1024 + c];
        const float w0 = cw[2048 + c], w1 = cw[3072 + 2048 + c], w2 = cw[2 * 3072 + 2048 + c], bs = cb[2048 + c];
#pragma unroll
        for (int q = 0; q < 8; ++q) {
            const int t0 = 32 * (mi0 + q) + 8 * fq;
            const f32x4 hx2 = hy_sc4(pc[q], t0 > 0 ? bf2f(pp[q]) : 0.f, (t0 + 8 < SEQ) ? bf2f(pn[q]) : 0.f, r, w0, w1, w2, bs);
            const float zh[4] = {bflo(zq[q].x), bfhi(zq[q].x), bflo(zq[q].y), bfhi(zq[q].y)};
#pragma unroll
            for (int j = 0; j < 4; ++j) {
                const int t = t0 + 2 * j + r;
                const float z = bf2f(*(const LAS bf16_t*)(ub + b * HY_PITCH + t * 2));
                float v = acc[q][j] + bias1 * z;
                if (r) v += bf2f(*(const LAS bf16_t*)(lds + HY_KR0 + HY_KRSZ + (2048 - t) * 2)) * z0;
                acc[q][j] = hx2[j] * v * zh[j];
            }
        }
    }
    {   unsigned pk[16];
#pragma unroll
        for (int q = 0; q < 8; ++q) { pk[2 * q] = cvt_pk_bf16(acc[q][0], acc[q][1]); pk[2 * q + 1] = cvt_pk_bf16(acc[q][2], acc[q][3]); }
        LAS unsigned char* yb = lds + HY_YB + tid * 16;
        if (ch < 3) {
#pragma unroll
            for (int k = 0; k < 4; ++k) *(LAS u32x4*)(yb + ch * 32768 + k * 8192) = (u32x4){pk[4 * k], pk[4 * k + 1], pk[4 * k + 2], pk[4 * k + 3]};
        } else {
#pragma unroll
            for (int k = 0; k < 4; ++k) {
                const u32x4 p0 = *(const LAS u32x4*)(yb + k * 8192), p1 = *(const LAS u32x4*)(yb + 32768 + k * 8192), p2 = *(const LAS u32x4*)(yb + 65536 + k * 8192);
#pragma unroll
                for (int e = 0; e < 4; ++e) {
                    const int q = 2 * k + (e >> 1), j0 = 2 * (e & 1);
                    const unsigned d0 = p0[e], d1 = p1[e], d2 = p2[e], d3 = pk[4 * k + e];
                    const int t = 32 * (mi0 + q) + 8 * fq + 2 * j0 + r;
                    bf16_t* yp = YH + (size_t)(b * SEQ + t) * HW + c4 * 4;
                    *(u32x2*)yp = (u32x2){(d0 & 0xffffu) | (d1 << 16), (d2 & 0xffffu) | (d3 << 16)};
                    *(u32x2*)(yp + 2 * HW) = (u32x2){(d0 >> 16) | (d1 & 0xffff0000u), (d2 >> 16) | (d3 & 0xffff0000u)};
                }
            }
            asm volatile("s_waitcnt vmcnt(0)" ::: "memory");
        }
    }
    }
}

constexpr int AT_PITCH = 272, AT_KS = 0, AT_VS = 128 * AT_PITCH;
__device__ void attn_item(LAS unsigned char* lds, const Args& a, int l, int item) {
    const int tid = opaque_tid(), lane = tid & 63, wid = __builtin_amdgcn_readfirstlane(tid >> 6), fr = lane & 15, fq = lane >> 4;
    const int hp = item & 3, qb = (item >> 2) & 15, b = item >> 6, kvh = hp >> 1, head = 2 * hp + (wid >> 2), qrow0 = 32 * (wid & 3);
    const bf16_t* Q = (const bf16_t*)(a.ws + WS_Q); const bf16_t* Kg = (const bf16_t*)(a.ws + WS_K); const bf16_t* VT = (const bf16_t*)(a.ws + WS_VT);
    const bf16_t* ZA = (const bf16_t*)(a.ws + WS_ZA); bf16_t* YA = (bf16_t*)(a.ws + WS_YA);
    constexpr float LOG2E = 1.4426950408889634f, SC2 = 0.08838834764831845f * LOG2E;
    bf16x8 qf[2][4];
#pragma unroll
    for (int qt = 0; qt < 2; ++qt)
#pragma unroll
        for (int ks = 0; ks < 4; ++ks)
            qf[qt][ks] = *(const bf16x8*)(Q + (size_t)(b * SEQ + qb * 128 + qrow0 + 16 * qt + fr) * 1024 + head * 128 + 32 * ks + 8 * fq);
    f32x4 O[2][8];
#pragma unroll
    for (int qt = 0; qt < 2; ++qt)
#pragma unroll
        for (int dt = 0; dt < 8; ++dt) O[qt][dt] = (f32x4){0.f, 0.f, 0.f, 0.f};
    const float sink2 = a.sink[l * 8 + head] * LOG2E;
    float mrun[2] = {sink2, sink2}, lsum[2] = {fq == 0 ? 1.f : 0.f, fq == 0 ? 1.f : 0.f};
    for (int rel = -1; rel <= 1; ++rel) {
        const int kt = qb + rel;
        if (kt < 0 || kt > 15) continue;
        __syncthreads();
#pragma unroll
        for (int i = 0; i < 4; ++i) {
            const int q = tid + 512 * i, row = q >> 4, ch = q & 15;
            *(LAS u32x4*)(lds + AT_KS + row * AT_PITCH + ch * 16) = *(const u32x4*)(Kg + (size_t)(b * SEQ + kt * 128 + row) * 256 + kvh * 128 + ch * 8);
            *(LAS u32x4*)(lds + AT_VS + row * AT_PITCH + ch * 16) = *(const u32x4*)(VT + (size_t)(kvh * 128 + row) * MTOK + b * SEQ + kt * 128 + ch * 8);
        }
        __syncthreads();
#pragma unroll 1
        for (int kh = 0; kh < 2; ++kh) {
            if ((rel < 0 && kh == 0 && qrow0 >= 64) || (rel > 0 && kh == 1 && qrow0 < 64)) continue;
            f32x4 S[2][4];
#pragma unroll
            for (int qt = 0; qt < 2; ++qt)
#pragma unroll
                for (int st = 0; st < 4; ++st) S[qt][st] = (f32x4){0.f, 0.f, 0.f, 0.f};
#pragma unroll
            for (int st = 0; st < 4; ++st)
#pragma unroll
                for (int ks = 0; ks < 4; ++ks) {
                    const bf16x8 kf = *(const LAS bf16x8*)(lds + AT_KS + (64 * kh + 16 * st + fr) * AT_PITCH + (32 * ks + 8 * fq) * 2);
#pragma unroll
                    for (int qt = 0; qt < 2; ++qt) S[qt][st] = __builtin_amdgcn_mfma_f32_16x16x32_bf16(kf, qf[qt][ks], S[qt][st], 0, 0, 0);
                }
            bf16x8 pf[2][2];
#pragma unroll
            for (int qt = 0; qt < 2; ++qt) {
                const int qq = qrow0 + 16 * qt + fr;
                float mx = -INFINITY;
#pragma unroll
                for (int st = 0; st < 4; ++st)
#pragma unroll
                    for (int j = 0; j < 4; ++j) {
                        const int kk = 64 * kh + 16 * st + 4 * fq + j;
                        const bool valid = (rel == 0) || (rel < 0 ? (kk >= qq) : (kk <= qq));
                        const float s = valid ? S[qt][st][j] * SC2 : -INFINITY;
                        S[qt][st][j] = s; mx = fmaxf(mx, s);
                    }
                mx = fmaxf(mx, __shfl_xor(mx, 16)); mx = fmaxf(mx, __shfl_xor(mx, 32));
                const float mnew = fmaxf(mrun[qt], mx), alpha = __builtin_amdgcn_exp2f(mrun[qt] - mnew);
                mrun[qt] = mnew;
                float ps = 0.f;
#pragma unroll
                for (int st = 0; st < 4; ++st)
#pragma unroll
                    for (int j = 0; j < 4; ++j) { const float p = __builtin_amdgcn_exp2f(S[qt][st][j] - mnew); S[qt][st][j] = p; ps += p; }
                lsum[qt] = lsum[qt] * alpha + ps;
#pragma unroll
                for (int dt = 0; dt < 8; ++dt) O[qt][dt] = O[qt][dt] * alpha;
#pragma unroll
                for (int kp = 0; kp < 2; ++kp) {
                    u32x4 w; w.x = cvt_pk_bf16(S[qt][2 * kp][0], S[qt][2 * kp][1]); w.y = cvt_pk_bf16(S[qt][2 * kp][2], S[qt][2 * kp][3]);
                    w.z = cvt_pk_bf16(S[qt][2 * kp + 1][0], S[qt][2 * kp + 1][1]); w.w = cvt_pk_bf16(S[qt][2 * kp + 1][2], S[qt][2 * kp + 1][3]);
                    pf[qt][kp] = __builtin_bit_cast(bf16x8, w);
                }
            }
#pragma unroll
            for (int kp = 0; kp < 2; ++kp)
#pragma unroll
                for (int dt = 0; dt < 8; ++dt) {
                    const LAS unsigned char* vp = lds + AT_VS + (16 * dt + fr) * AT_PITCH + (64 * kh + 32 * kp + 4 * fq) * 2;
                    const u32x2 v0 = *(const LAS u32x2*)vp, v1 = *(const LAS u32x2*)(vp + 32);
                    const u32x4 vv = {v0.x, v0.y, v1.x, v1.y};
                    const bf16x8 vf = __builtin_bit_cast(bf16x8, vv);
#pragma unroll
                    for (int qt = 0; qt < 2; ++qt) O[qt][dt] = __builtin_amdgcn_mfma_f32_16x16x32_bf16(vf, pf[qt][kp], O[qt][dt], 0, 0, 0);
                }
        }
    }
#pragma unroll
    for (int qt = 0; qt < 2; ++qt) {
        float ls = lsum[qt]; ls += __shfl_xor(ls, 16); ls += __shfl_xor(ls, 32);
        const float inv = 1.f / ls;
        const size_t rowoff = (size_t)(b * SEQ + qb * 128 + qrow0 + 16 * qt + fr) * 1024 + head * 128 + 4 * fq;
        u32x2 zv[8];
#pragma unroll
        for (int dt = 0; dt < 8; ++dt) zv[dt] = *(const u32x2*)(ZA + rowoff + 16 * dt);
        asm volatile("s_waitcnt vmcnt(0)" ::: "memory");
#pragma unroll
        for (int dt = 0; dt < 8; ++dt) {
            const u32x2 z = zv[dt];
            const f32x4 o = O[qt][dt] * inv;
            u32x2 w; w.x = cvt_pk_bf16(o[0] * bflo(z.x), o[1] * bfhi(z.x)); w.y = cvt_pk_bf16(o[2] * bflo(z.y), o[3] * bfhi(z.y));
            *(u32x2*)(YA + rowoff + 16 * dt) = w;
        }
        asm volatile("s_waitcnt vmcnt(0)" ::: "memory");
    }
}

__device__ void mix_phase(LAS unsigned char* lds, const Args& a, int l, int G, int bid) {
    const int vcu = (G % 8 == 0) ? (bid % 8) * (G / 8) + bid / 8 : bid;
    for (int it = vcu; it < 256 + 512; it += G) {
        if (it < 256) { hyena_item(lds, a, l, it); if (PROBE_DUP == 8) hyena_item(lds, a, l, it); }
        else { attn_item(lds, a, l, it - 256); if (PROBE_DUP == 9) attn_item(lds, a, l, it - 256); }
    }
    __syncthreads();
}


#define XB_TMO      128
#define XB_XCNT(j)  (256  + 64 * (j))
#define XB_XSUB(j)  (1280 + 64 * (j))
#define XB_XGEN(j)  (2304 + 64 * (j))
#define XB_TOP      3328
#define XB_TOPGEN   3392
#define XCD_BAR_WORDS 3456
#define XB_SPIN_CAP (1u << 21)
__device__ __forceinline__ unsigned xb_ld(unsigned* p)              { return __hip_atomic_load(p, __ATOMIC_RELAXED, __HIP_MEMORY_SCOPE_AGENT); }
__device__ __forceinline__ unsigned xb_add(unsigned* p, unsigned v) { return __hip_atomic_fetch_add(p, v, __ATOMIC_RELAXED, __HIP_MEMORY_SCOPE_AGENT); }
__device__ __forceinline__ unsigned xb_xcc_id() { return (unsigned)__builtin_amdgcn_s_getreg((3 << 11) | 20) & 0xFu; }
#define XB_SPIN(cond, bar) do { unsigned _sp = 0; while (cond) { __builtin_amdgcn_s_sleep(1); \
    if ((++_sp & 255u) == 0u) { if (xb_ld(&(bar)[XB_TMO])) break; if (_sp > XB_SPIN_CAP) { atomicAdd(&(bar)[XB_TMO], 1u); break; } } } } while (0)
struct XcdBarrier { unsigned* bar; unsigned x; volatile LAS unsigned* st; };
__device__ __forceinline__ XcdBarrier xcd_barrier_post(unsigned* bar, volatile LAS unsigned* st) {
    XcdBarrier b; b.bar = bar; b.x = xb_xcc_id(); b.st = st;
    if (threadIdx.x == 0) (void)xb_add(&bar[XB_XCNT(b.x)], 1u);
    return b;
}
__device__ __forceinline__ void xcd_barrier_complete(unsigned* bar, unsigned x, unsigned& nloc, unsigned& nx) {
    const unsigned G = gridDim.x * gridDim.y * gridDim.z;
    unsigned sum, cnt, mine, sp = 0u;
    for (;;) {
        sum = 0u; cnt = 0u; mine = 0u;
#pragma unroll
        for (unsigned j = 0; j < 16; ++j) { const unsigned c = xb_ld(&bar[XB_XCNT(j)]); sum += c; cnt += (c > 0u) ? 1u : 0u; mine = (j == x) ? c : mine; }
        if (sum == G) break;
        __builtin_amdgcn_s_sleep(1);
        if ((++sp & 255u) == 0u) { if (xb_ld(&bar[XB_TMO])) break; if (sp > XB_SPIN_CAP) { atomicAdd(&bar[XB_TMO], 1u); break; } }
    }
    nloc = mine > 0u ? mine : 1u; nx = cnt > 0u ? cnt : 1u;
}
__device__ __forceinline__ void xcd_barrier(const XcdBarrier& b) {
    asm volatile("s_waitcnt vmcnt(0)" ::: "memory");
    __syncthreads();
    if (threadIdx.x == 0) {
        unsigned* bar = b.bar;
        __builtin_amdgcn_s_waitcnt(0);
        unsigned nloc = b.st[0], nx = b.st[1];
        if (nloc == 0u) { xcd_barrier_complete(bar, b.x, nloc, nx); b.st[0] = nloc; b.st[1] = nx; }
        const unsigned old = xb_add(&bar[XB_XSUB(b.x)], 1u);
        const unsigned gen = old / nloc;
        if (old + 1u == (gen + 1u) * nloc) {
            __builtin_amdgcn_fence(__ATOMIC_RELEASE, "agent");
            asm volatile("s_waitcnt vmcnt(0)" ::: "memory");
            const unsigned og = xb_add(&bar[XB_TOP], 1u);
            const unsigned tg = og / nx;
            if (og + 1u == (tg + 1u) * nx) xb_add(&bar[XB_TOPGEN], 1u);
            else XB_SPIN(xb_ld(&bar[XB_TOPGEN]) == tg, bar);
            __builtin_amdgcn_fence(__ATOMIC_ACQUIRE, "agent");
            xb_add(&bar[XB_XGEN(b.x)], 1u);
            asm volatile("s_waitcnt vmcnt(0)" ::: "memory");
        } else {
            XB_SPIN(xb_ld(&bar[XB_XGEN(b.x)]) == gen, bar);
            __builtin_amdgcn_fence(__ATOMIC_ACQUIRE, "agent");
            asm volatile("s_waitcnt vmcnt(0)" ::: "memory");
        }
    }
    __syncthreads();
}

__global__ void __launch_bounds__(512, 2) hybrid_fwd(Args a) {
    extern __shared__ __attribute__((aligned(16))) unsigned char lds_raw[];
    LAS unsigned char* lds = (LAS unsigned char*)lds_raw;
    const int G = gridDim.x, bid = blockIdx.x;
    unsigned char* ws = a.ws;
    {   volatile LAS unsigned* st0 = (volatile LAS unsigned*)(lds + LDS_ST); if (threadIdx.x < 2) st0[threadIdx.x] = 0u; }
    __syncthreads();
    XcdBarrier xbar = xcd_barrier_post((unsigned*)(ws + WS_BAR), (volatile LAS unsigned*)(lds + LDS_ST));
    if (a.ph_lo < 0) cg::this_grid().sync();
    bool redo = false;
    for (int ph = a.ph_lo; ph < a.ph_hi; ++ph) {
        bool sync_after = true;
        const int l = (ph < 6) ? 0 : 1, k = (ph < 6) ? ph - 1 : ph - 7;
        const int kind = (ph == 0) ? 1 : (ph == NPHASE - 1) ? 6 : (ph == 6) ? 11 : (k == 0) ? 2 : (k == 1) ? 3 : (k == 4) ? 5 : 4;
        const int nrep = (PROBE_DUP != 0 && PROBE_DUP != 4 && PROBE_DUP == kind) ? 2 : 1;
        for (int rep = 0; rep < nrep; ++rep) {
        if (ph == 0) prologue(lds, a, G, bid);
        else if (ph == 6) ssq_reduce(a, bid);
        else if (ph == NPHASE - 1) { final_norm(a, G, bid, (PROBE_DUP == 6 && rep == 0) ? (float*)(ws + WS_UT) : a.out); sync_after = false; }
        else {
            if (k == 1) mix_phase(lds, a, l, G, bid);
            else {
                pg8::Sched S; pg8::Epi E;
                E.l = l; E.ws = ws; E.xold = (l == 0) ? a.x : a.out; E.noss = (rep + 1 < nrep); E.xnew = (PROBE_DUP == 5 && E.noss) ? (float*)(ws + WS_GH) : a.out;
                if (k == 0) { E.mode = 0; S.init(0, NIN, DM, ws + WS_XB, (bf16_t*)(ws + WS_WIN) + (size_t)l * NIN * DM); }
                else if (k == 2) { E.mode = 1; S.init(1, DM, HW, ws + WS_YH, (bf16_t*)(ws + WS_WH) + (size_t)l * DM * HW); sync_after = false; }
                else if (k == 3) { E.mode = 2; S.init(1, DM, HW, ws + WS_YA, (bf16_t*)(ws + WS_WA) + (size_t)l * DM * HW); }
                else { E.mode = 3; S.init(1, DM, DM, ws + WS_MG, (bf16_t*)(ws + WS_WO) + (size_t)l * DM * DM); }
                pg8::gemm_phase(lds, S, E);
            }
        }
        }
        if (PROBE_DUP == 4 && kind == 4 && k == 3) { if (!redo) { redo = true; ph -= 2; continue; } redo = false; }
        if (sync_after && ph + 1 < a.ph_hi) { xcd_barrier(xbar); if (PROBE_DUP == 7) xcd_barrier(xbar); }
    }
}

extern "C" void kernel_launch(void* const* d_in, const int* in_sizes, int n_in, void* d_out, int out_size, void* d_ws, size_t ws_size, hipStream_t stream) {
    static int grid = 0;
    if (grid == 0) {
        if (n_in != 19 || out_size != MTOK * DM || ws_size < WS_END) { fprintf(stderr, "kernel_launch: unexpected shapes (n_in %d out %d ws %zu)\n", n_in, out_size, ws_size); grid = -1; return; }
        int dev = 0, cus = 0, per_cu = 0;
        hipGetDevice(&dev); hipDeviceGetAttribute(&cus, hipDeviceAttributeMultiprocessorCount, dev);
        if (hipFuncSetAttribute((const void*)hybrid_fwd, hipFuncAttributeMaxDynamicSharedMemorySize, LDS_BYTES) != hipSuccess) { fprintf(stderr, "kernel_launch: hipFuncSetAttribute failed\n"); grid = -1; return; }
        if (hipOccupancyMaxActiveBlocksPerMultiprocessor(&per_cu, (const void*)hybrid_fwd, 512, LDS_BYTES) != hipSuccess || per_cu < 1) { fprintf(stderr, "kernel_launch: occupancy query gave %d\n", per_cu); per_cu = 1; }
        (void)hipGetLastError();
        grid = cus * 1;
        if (grid <= 0) grid = 256;
    }
    if (grid < 0) return;
    if (hipMemsetAsync((char*)d_ws + WS_BAR, 0, 16384, stream) != hipSuccess) { fprintf(stderr, "kernel_launch: memset of barrier words failed\n"); return; }
    Args a{};
    const float** slots = (const float**)&a;
    for (int i = 0; i < 19; ++i) slots[i] = (const float*)d_in[i];
    a.out = (float*)d_out; a.ws = (unsigned char*)d_ws;
#if MK_MULTI
    for (int ph = 0; ph < NPHASE; ++ph) { a.ph_lo = ph; a.ph_hi = ph + 1; hipLaunchKernelGGL(hybrid_fwd, dim3(grid), dim3(512), LDS_BYTES, stream, a); }
#else
    a.ph_lo = 0; a.ph_hi = NPHASE;
    void* args[] = {&a};
    hipError_t e = hipLaunchCooperativeKernel((const void*)hybrid_fwd, dim3(grid), dim3(512), args, LDS_BYTES, stream);
    if (e != hipSuccess) fprintf(stderr, "cooperative launch failed: %s (grid %d)\n", hipGetErrorString(e), grid);
#endif
}
```

```cpp
#include <hip/hip_runtime.h>
#include <hip/hip_cooperative_groups.h>
#include <cstdio>
#include <cstdint>
namespace cg = cooperative_groups;

#define LAS __attribute__((address_space(3)))
typedef unsigned short bf16_t;
typedef short bf16x8 __attribute__((ext_vector_type(8)));
typedef float f32x4 __attribute__((ext_vector_type(4)));
typedef unsigned u32x4 __attribute__((ext_vector_type(4)));
typedef unsigned u32x2 __attribute__((ext_vector_type(2)));

#ifndef PROBE_DUP
#define PROBE_DUP 0
#endif
#ifndef MK_MULTI
#define MK_MULTI 0
#endif

constexpr int SEQ = 2048, DM = 2048, NB = 8, MTOK = NB * SEQ, NIN = 10752, HW = 1024;
constexpr float EPS = 1e-6f;
constexpr size_t MiB = 1u << 20;
constexpr size_t WS_WIN = 0, WS_WH = 84 * MiB, WS_WA = 92 * MiB, WS_WO = 100 * MiB, WS_KR = 116 * MiB, WS_ROPE = 148 * MiB, WS_SSQ = 148 * MiB + 512 * 1024,
                 WS_BAR = 149 * MiB, WS_XB = 150 * MiB, WS_UT = 214 * MiB, WS_MG = 214 * MiB, WS_VT = 342 * MiB, WS_Q = 350 * MiB, WS_K = 382 * MiB, WS_ZA = 390 * MiB,
                 WS_GH = 422 * MiB, WS_GA = 486 * MiB, WS_YH = 550 * MiB, WS_YA = 582 * MiB, WS_SSQP = 614 * MiB, WS_END = 616 * MiB;
constexpr int LDS_BYTES = 149504, LDS_ST = 148544;
constexpr int NPHASE = 13;

struct Args {
    const float* x; const float* norm_g; const float* w_in; const float* conv_w; const float* conv_b;
    const float* fw1; const float* fb1; const float* fw2; const float* fb2; const float* fw3; const float* fb3; const float* fw4; const float* ffreq;
    const float* hbias; const float* sink; const float* w_hy; const float* w_at; const float* w_out; const float* fnorm;
    float* out; unsigned char* ws; int ph_lo, ph_hi;
};

__device__ __forceinline__ unsigned cvt_pk_bf16(float lo, float hi) { unsigned r; asm("v_cvt_pk_bf16_f32 %0, %1, %2" : "=v"(r) : "v"(lo), "v"(hi)); return r; }
__device__ __forceinline__ bf16_t f2bf(float v) { return (bf16_t)(cvt_pk_bf16(v, 0.f) & 0xffffu); }
__device__ __forceinline__ float bf2f(unsigned h) { return __uint_as_float(h << 16); }
__device__ __forceinline__ float bflo(unsigned w) { return __uint_as_float(w << 16); }
__device__ __forceinline__ float bfhi(unsigned w) { return __uint_as_float(w & 0xffff0000u); }
__device__ __forceinline__ int opaque_tid() { int t; asm volatile("v_mov_b32 %0, %1" : "=v"(t) : "v"(threadIdx.x)); return t; }
__device__ __forceinline__ float sin_rr(float x) { double r = (double)x * 0.15915494309189535; r -= rint(r); return __builtin_amdgcn_sinf((float)r); }
__device__ __forceinline__ float cos_rr(float x) { double r = (double)x * 0.15915494309189535; r -= rint(r); return __builtin_amdgcn_cosf((float)r); }
__device__ __forceinline__ float sigmoidf_(float x) { return __builtin_amdgcn_rcpf(1.f + __expf(-x)); }
__device__ __forceinline__ float siluf_(float x) { return x * sigmoidf_(x); }

namespace pg8 {
constexpr int BM = 256, BK = 64, HALF = 128, HTB = HALF * BK * 2, NXCD = 8, WGM = 8;
__host__ __device__ __forceinline__ int lds_byte(int r, int c) { const int st = (r >> 4) * 2 + (c >> 5), rr = r & 15, cc = c & 31, ob = rr * 64 + cc * 2; return st * 1024 + (ob ^ (((ob >> 9) & 1) << 5)); }
__host__ __device__ __forceinline__ void stage_rc(int b, int& R, int& C) { const int st = b / 1024, sb = b % 1024, swz = sb ^ (((sb >> 9) & 1) << 5); R = (st >> 1) * 16 + swz / 64; C = (st & 1) * 32 + (swz % 64) / 2; }
__host__ __device__ __forceinline__ int perm32(int rho) { const int n = rho >> 4, i = rho & 15; return 8 * (i >> 2) + 4 * n + (i & 3); }

struct Unit { const char* a; const char* b; int pm, pn; };

struct Sched {
    int mode, nN, K; const char* A; const char* B;
    __device__ __forceinline__ void init(int mode_, int N, int K_, const void* A_, const void* B_) { mode = mode_; nN = N / BM; K = K_; A = (const char*)A_; B = (const char*)B_; }
    __device__ __forceinline__ bool next(int i, Unit& u) const {
        const int nM = MTOK / BM, nwg = nM * nN, G = gridDim.x;
        const long L = (long)i * G + blockIdx.x; if (L >= nwg) return false;
        int wgid = (int)L; { const int q = nwg / NXCD, r = nwg % NXCD, xcd = wgid % NXCD, off = wgid / NXCD; wgid = (xcd < r ? xcd * (q + 1) : r * (q + 1) + (xcd - r) * q) + off; }
        const int nig = WGM * nN, gid = wgid / nig, fm = gid * WGM, gsz = (nM - fm) < WGM ? (nM - fm) : WGM;
        u.pm = fm + ((wgid % nig) % gsz); u.pn = (wgid % nig) / gsz;
        const bool tr = (mode == 0) && (u.pn < 16 || u.pn == 21);
        const size_t tstep = (size_t)BM * K * 2;
        const char* pa = A + (size_t)u.pm * tstep; const char* pb = B + (size_t)u.pn * tstep;
        u.a = tr ? pb : pa; u.b = tr ? pa : pb; return true;
    }
};

struct Epi {
    int mode, l;
    unsigned char* ws; const float* xold; float* xnew; int noss;

    __device__ __forceinline__ void operator()(const f32x4 (&acc)[2][2][4][2], const Unit& u) const {
        int tid_; asm volatile("v_mov_b32 %0, %1" : "=v"(tid_) : "v"(threadIdx.x));
        const int wid_ = tid_ >> 6, lane_ = tid_ & 63, wr = wid_ >> 2, wc = wid_ & 3, fr = lane_ & 15, fq = lane_ >> 4;
        const int rloc0 = wr * 64 + fr, cloc0 = wc * 32 + 8 * fq;
        if (mode == 0) {
            const float* ssq = (const float*)(ws + WS_SSQ) + (size_t)l * MTOK;
            if (u.pn < 16 || u.pn == 21) {
                bf16_t* base = (u.pn == 21) ? (bf16_t*)(ws + WS_VT) : ((bf16_t*)(ws + WS_UT) + (size_t)u.pn * 256 * MTOK);
                const bool act = (u.pn >= 12 && u.pn < 16);
                const int tok0 = u.pm * 256 + cloc0;
                f32x4 rr[2][2];
#pragma unroll
                for (int bj = 0; bj < 2; ++bj) { rr[bj][0] = *(const f32x4*)(ssq + tok0 + bj * HALF); rr[bj][1] = *(const f32x4*)(ssq + tok0 + bj * HALF + 4); }
                asm volatile("s_waitcnt vmcnt(0)" ::: "memory");
#pragma unroll
                for (int bj = 0; bj < 2; ++bj)
#pragma unroll
                    for (int h = 0; h < 2; ++h)
#pragma unroll
                        for (int e = 0; e < 4; ++e) rr[bj][h][e] = __builtin_amdgcn_rsqf(rr[bj][h][e] * (1.f / DM) + EPS);
#pragma unroll
                for (int bj = 0; bj < 2; ++bj)
#pragma unroll
                    for (int ai = 0; ai < 2; ++ai)
#pragma unroll
                        for (int m = 0; m < 4; ++m) {
                            f32x4 v0 = acc[ai][bj][m][0] * rr[bj][0], v1 = acc[ai][bj][m][1] * rr[bj][1];
                            if (act) {
#pragma unroll
                                for (int e = 0; e < 4; ++e) { v0[e] = siluf_(v0[e]); v1[e] = siluf_(v1[e]); } }
                            u32x4 w; w.x = cvt_pk_bf16(v0[0], v0[1]); w.y = cvt_pk_bf16(v0[2], v0[3]); w.z = cvt_pk_bf16(v1[0], v1[1]); w.w = cvt_pk_bf16(v1[2], v1[3]);
                            *(u32x4*)(base + (size_t)(rloc0 + ai * HALF + m * 16) * MTOK + tok0 + bj * HALF) = w;
                        }
            } else {
                const int pn = u.pn; bf16_t* base; int ld; int act;
                if (pn < 20) { base = (bf16_t*)(ws + WS_Q) + (pn - 16) * 256; ld = 1024; act = 1; }
                else if (pn == 20) { base = (bf16_t*)(ws + WS_K); ld = 256; act = 1; }
                else if (pn < 26) { base = (bf16_t*)(ws + WS_ZA) + (pn - 22) * 256; ld = 1024; act = 2; }
                else if (pn < 34) { base = (bf16_t*)(ws + WS_GH) + (pn - 26) * 256; ld = 2048; act = 3; }
                else { base = (bf16_t*)(ws + WS_GA) + (pn - 34) * 256; ld = 2048; act = 3; }
                const float* rope = (const float*)(ws + WS_ROPE);
                float rsv[8];
#pragma unroll
                for (int it = 0; it < 8; ++it) rsv[it] = ssq[u.pm * 256 + rloc0 + (it >> 2) * HALF + (it & 3) * 16];
                asm volatile("s_waitcnt vmcnt(0)" ::: "memory");
#pragma unroll
                for (int it = 0; it < 8; ++it) rsv[it] = __builtin_amdgcn_rsqf(rsv[it] * (1.f / DM) + EPS);
#pragma unroll
                for (int ai = 0; ai < 2; ++ai)
#pragma unroll
                    for (int m = 0; m < 4; ++m) {
                        const int row = u.pm * 256 + rloc0 + ai * HALF + m * 16;
                        const float rs = rsv[ai * 4 + m];
                        f32x4 c0 = {1.f, 1.f, 1.f, 1.f}, c1 = c0, sn0 = {0.f, 0.f, 0.f, 0.f}, sn1 = sn0;
                        if (act == 1 && wc == 0) { const float* rp = rope + (size_t)(row & (SEQ - 1)) * 32 + 8 * (fq & 1);
                            c0 = *(const f32x4*)rp; c1 = *(const f32x4*)(rp + 4); sn0 = *(const f32x4*)(rp + 16); sn1 = *(const f32x4*)(rp + 20);
                            asm volatile("s_waitcnt vmcnt(0)" ::: "memory");
                            if (fq < 2) { sn0 = -sn0; sn1 = -sn1; } }
#pragma unroll
                        for (int bj = 0; bj < 2; ++bj) {
                            f32x4 v0 = acc[ai][bj][m][0] * rs, v1 = acc[ai][bj][m][1] * rs;
                            if (act == 1) {
                                if (wc == 0) {
                                    f32x4 p0, p1;
#pragma unroll
                                    for (int e = 0; e < 4; ++e) { p0[e] = __shfl_xor(v0[e], 32); p1[e] = __shfl_xor(v1[e], 32); }
                                    v0 = v0 * c0 + p0 * sn0; v1 = v1 * c1 + p1 * sn1;
                                }
                            } else if (act == 2) {
#pragma unroll
                                for (int e = 0; e < 4; ++e) { v0[e] = siluf_(v0[e]); v1[e] = siluf_(v1[e]); }
                            } else if (act == 3) {
#pragma unroll
                                for (int e = 0; e < 4; ++e) { v0[e] = sigmoidf_(v0[e]); v1[e] = sigmoidf_(v1[e]); }
                            }
                            u32x4 w; w.x = cvt_pk_bf16(v0[0], v0[1]); w.y = cvt_pk_bf16(v0[2], v0[3]); w.z = cvt_pk_bf16(v1[0], v1[1]); w.w = cvt_pk_bf16(v1[2], v1[3]);
                            *(u32x4*)(base + (size_t)row * ld + cloc0 + bj * HALF) = w;
                        }
                        if (act == 1) asm volatile("" ::: "memory");
                    }
            }
        } else if (mode == 1 || mode == 2) {
            bf16_t* MG = (bf16_t*)(ws + WS_MG); const bf16_t* G = (const bf16_t*)(ws + (mode == 1 ? WS_GH : WS_GA));
            const size_t off0 = (size_t)(u.pm * 256 + rloc0) * DM + u.pn * 256 + cloc0;
#define EPI_ROWOFF(it) (off0 + (size_t)(((it) >> 2) * HALF + ((it) & 3) * 16) * DM)
#pragma unroll
            for (int ai = 0; ai < 2; ++ai) {
                u32x4 gb[4][2], pb[4][2];
#pragma unroll
                for (int m = 0; m < 4; ++m)
#pragma unroll
                    for (int bj = 0; bj < 2; ++bj) { gb[m][bj] = *(const u32x4*)(G + EPI_ROWOFF(ai * 4 + m) + bj * HALF); if (mode == 2) pb[m][bj] = *(const u32x4*)(MG + EPI_ROWOFF(ai * 4 + m) + bj * HALF); }
                asm volatile("s_waitcnt vmcnt(0)" ::: "memory");
#pragma unroll
                for (int m = 0; m < 4; ++m)
#pragma unroll
                    for (int bj = 0; bj < 2; ++bj) {
                        const u32x4 g = gb[m][bj];
                        f32x4 v0 = acc[ai][bj][m][0], v1 = acc[ai][bj][m][1];
                        v0[0] *= bflo(g.x); v0[1] *= bfhi(g.x); v0[2] *= bflo(g.y); v0[3] *= bfhi(g.y);
                        v1[0] *= bflo(g.z); v1[1] *= bfhi(g.z); v1[2] *= bflo(g.w); v1[3] *= bfhi(g.w);
                        if (mode == 2) { const u32x4 p = pb[m][bj];
                            v0[0] += bflo(p.x); v0[1] += bfhi(p.x); v0[2] += bflo(p.y); v0[3] += bfhi(p.y);
                            v1[0] += bflo(p.z); v1[1] += bfhi(p.z); v1[2] += bflo(p.w); v1[3] += bfhi(p.w); }
                        u32x4 w; w.x = cvt_pk_bf16(v0[0], v0[1]); w.y = cvt_pk_bf16(v0[2], v0[3]); w.z = cvt_pk_bf16(v1[0], v1[1]); w.w = cvt_pk_bf16(v1[2], v1[3]);
                        *(u32x4*)(MG + EPI_ROWOFF(ai * 4 + m) + bj * HALF) = w;
                    }
                asm volatile("s_waitcnt vmcnt(0)" ::: "memory");
            }
        } else {
            bf16_t* XB = (bf16_t*)(ws + WS_XB); float* ssqp = (float*)(ws + WS_SSQP);
            const size_t off0 = (size_t)(u.pm * 256 + rloc0) * DM + u.pn * 256 + cloc0;
#pragma unroll
            for (int ai = 0; ai < 2; ++ai) {
                f32x4 xb[4][2][2];
#pragma unroll
                for (int m = 0; m < 4; ++m)
#pragma unroll
                    for (int bj = 0; bj < 2; ++bj) { xb[m][bj][0] = *(const f32x4*)(xold + EPI_ROWOFF(ai * 4 + m) + bj * HALF); xb[m][bj][1] = *(const f32x4*)(xold + EPI_ROWOFF(ai * 4 + m) + bj * HALF + 4); }
                asm volatile("s_waitcnt vmcnt(0)" ::: "memory");
#pragma unroll
                for (int m = 0; m < 4; ++m) {
                    const int row = u.pm * 256 + rloc0 + ai * HALF + m * 16;
                    const size_t off = EPI_ROWOFF(ai * 4 + m);
                    float ss = 0.f;
#pragma unroll
                    for (int bj = 0; bj < 2; ++bj) {
                        const f32x4 v0 = acc[ai][bj][m][0] + xb[m][bj][0], v1 = acc[ai][bj][m][1] + xb[m][bj][1];
                        *(f32x4*)(xnew + off + bj * HALF) = v0; *(f32x4*)(xnew + off + bj * HALF + 4) = v1;
                        u32x4 w; w.x = cvt_pk_bf16(v0[0], v0[1]); w.y = cvt_pk_bf16(v0[2], v0[3]); w.z = cvt_pk_bf16(v1[0], v1[1]); w.w = cvt_pk_bf16(v1[2], v1[3]);
                        if (l == 0) *(u32x4*)(XB + off + bj * HALF) = w;
                        ss += (v0[0] * v0[0] + v0[1] * v0[1]) + (v0[2] * v0[2] + v0[3] * v0[3]) + (v1[0] * v1[0] + v1[1] * v1[1]) + (v1[2] * v1[2] + v1[3] * v1[3]);
                    }
                    ss += __shfl_xor(ss, 16); ss += __shfl_xor(ss, 32);
                    if (fq == 0) ssqp[(size_t)row * 32 + u.pn * 4 + wc] = ss;
                }
                asm volatile("s_waitcnt vmcnt(0)" ::: "memory");
            }
#undef EPI_ROWOFF
        }
        asm volatile("s_waitcnt vmcnt(0)" ::: "memory");
    }
};

__device__ __forceinline__ void gemm_phase(LAS unsigned char* lds, const Sched& S, const Epi& E) {
    const int K = S.K;
    const int tid = opaque_tid(), wid = __builtin_amdgcn_readfirstlane(tid >> 6), lane = tid & 63, wr = wid >> 2, wc = wid & 3, fr = lane & 15, fq = lane >> 4;
    const int nt = K / BK;
    unsigned voffA[2], voffB[2];
#pragma unroll
    for (int i = 0; i < 2; ++i) { int R, C; stage_rc(tid * 16 + i * 8192, R, C); const int Rb = (R & ~31) + perm32(R & 31);
        voffA[i] = (unsigned)(R * K + C) * 2u; voffB[i] = (unsigned)(Rb * K + C) * 2u; }
    const size_t kstep = (size_t)(BK * 2);
    const size_t hstep = (size_t)HALF * K * 2;
    const unsigned ldsw = (unsigned)wid * 1024u;
    const int aoff = lds_byte(wr * 64 + fr, fq * 8), boff = lds_byte(wc * 32 + fr, fq * 8);
#define PG8_SA(b, h) (((b) * 2 + (h)) * HTB)
#define PG8_SB(b, h) ((4 + (b) * 2 + (h)) * HTB)
#define PG8_STAGE(bufoff, gbase, voff) do { _Pragma("unroll") for (int _i = 0; _i < 2; ++_i) \
        __builtin_amdgcn_global_load_lds((const unsigned*)((const char*)(gbase) + (voff)[_i]), (LAS unsigned*)(lds + (bufoff) + ldsw + _i * 8192), 16, 0, 0); } while (0)
#define PG8_LDA(dst, b, h) do { _Pragma("unroll") for (int m = 0; m < 4; ++m) _Pragma("unroll") for (int k = 0; k < 2; ++k) dst[m][k] = *(const LAS bf16x8*)(lds + PG8_SA(b, h) + aoff + m * 2048 + k * 1024); } while (0)
#define PG8_LDB(dst, b, h) do { _Pragma("unroll") for (int n = 0; n < 2; ++n) _Pragma("unroll") for (int k = 0; k < 2; ++k) dst[n][k] = *(const LAS bf16x8*)(lds + PG8_SB(b, h) + boff + n * 2048 + k * 1024); } while (0)
#define PG8_MMA(ai, bj, At, Bt) do { __builtin_amdgcn_s_setprio(1); _Pragma("unroll") for (int m = 0; m < 4; ++m) _Pragma("unroll") for (int n = 0; n < 2; ++n) _Pragma("unroll") for (int k = 0; k < 2; ++k) \
        acc[ai][bj][m][n] = __builtin_amdgcn_mfma_f32_16x16x32_bf16(Bt[n][k], At[m][k], acc[ai][bj][m][n], 0, 0, 0); __builtin_amdgcn_s_setprio(0); } while (0)
#define PG8_WAIT_V(n) asm volatile("s_waitcnt vmcnt(" #n ")" ::: "memory")
#define PG8_WAIT_L(n) asm volatile("s_waitcnt lgkmcnt(" #n ")" ::: "memory")
#define PG8_BAR __builtin_amdgcn_s_barrier()
#define PG8_SCHED __builtin_amdgcn_sched_barrier(0)
    Unit cur, nxt; int ui = 0;
    if (!S.next(0, cur)) return;
    f32x4 acc[2][2][4][2];
#pragma unroll
    for (int a = 0; a < 2; ++a)
#pragma unroll
        for (int b = 0; b < 2; ++b)
#pragma unroll
            for (int m = 0; m < 4; ++m)
#pragma unroll
                for (int n = 0; n < 2; ++n) acc[a][b][m][n] = (f32x4){0.f, 0.f, 0.f, 0.f};
    bf16x8 At[4][2], B0[2][2], B1[2][2];
    const char* cA = cur.a; const char* cB = cur.b;
    PG8_STAGE(PG8_SB(0, 0), cB, voffB); PG8_STAGE(PG8_SB(0, 1), cB + hstep, voffB); PG8_STAGE(PG8_SA(0, 0), cA, voffA); PG8_STAGE(PG8_SA(0, 1), cA + hstep, voffA);
    if (wr == 1) PG8_BAR;
    PG8_WAIT_V(2); PG8_BAR;
    PG8_STAGE(PG8_SB(1, 0), cB + kstep, voffB); PG8_STAGE(PG8_SA(1, 0), cA + kstep, voffA); PG8_STAGE(PG8_SB(1, 1), cB + hstep + kstep, voffB);
    PG8_WAIT_V(6); PG8_BAR;
    for (;;) {
        const bool has_next = S.next(ui + 1, nxt);
        const char* nA = has_next ? nxt.a : cA; const char* nB = has_next ? nxt.b : cB;
        for (int t = 0; t < nt; t += 2) {
            const bool last = (t == nt - 2);
            const char* a1 = cA + (size_t)(t + 1) * kstep;
            const char* a2 = last ? nA : cA + (size_t)(t + 2) * kstep; const char* b2 = last ? nB : cB + (size_t)(t + 2) * kstep;
            const char* a3 = a2 + kstep; const char* b3 = b2 + kstep;
            PG8_LDB(B0, 0, 0); PG8_LDB(B1, 0, 1); PG8_SCHED; PG8_LDA(At, 0, 0); PG8_STAGE(PG8_SA(1, 1), a1 + hstep, voffA);
            PG8_WAIT_V(8); PG8_WAIT_L(0); PG8_BAR; PG8_MMA(0, 0, At, B0); PG8_MMA(0, 1, At, B1); PG8_BAR; PG8_SCHED;
            PG8_LDA(At, 0, 1); PG8_STAGE(PG8_SB(0, 0), b2, voffB); PG8_STAGE(PG8_SB(0, 1), b2 + hstep, voffB); PG8_STAGE(PG8_SA(0, 0), a2, voffA);
            PG8_WAIT_V(8); PG8_WAIT_L(0); PG8_BAR; PG8_MMA(1, 0, At, B0); PG8_MMA(1, 1, At, B1); PG8_BAR; PG8_SCHED;
            PG8_LDB(B0, 1, 0); PG8_LDB(B1, 1, 1); PG8_SCHED; PG8_LDA(At, 1, 0); PG8_STAGE(PG8_SA(0, 1), a2 + hstep, voffA);
            PG8_WAIT_V(8); PG8_WAIT_L(0); PG8_BAR; PG8_MMA(0, 0, At, B0); PG8_MMA(0, 1, At, B1); PG8_BAR; PG8_SCHED;
            PG8_LDA(At, 1, 1); PG8_STAGE(PG8_SB(1, 0), b3, voffB); PG8_STAGE(PG8_SB(1, 1), b3 + hstep, voffB); PG8_STAGE(PG8_SA(1, 0), a3, voffA);
            PG8_WAIT_V(8); PG8_WAIT_L(0); PG8_BAR; PG8_MMA(1, 0, At, B0); PG8_MMA(1, 1, At, B1); PG8_BAR; PG8_SCHED;
        }
        if (wr == 0) PG8_BAR;
        E(acc, cur);
        if (!has_next) break;
#pragma unroll
        for (int a = 0; a < 2; ++a)
#pragma unroll
            for (int b = 0; b < 2; ++b)
#pragma unroll
                for (int m = 0; m < 4; ++m)
#pragma unroll
                    for (int n = 0; n < 2; ++n) acc[a][b][m][n] = (f32x4){0.f, 0.f, 0.f, 0.f};
        cur = nxt; cA = nA; cB = nB; ++ui;
        if (wr == 1) PG8_BAR;
    }
    PG8_WAIT_V(0);
    PG8_BAR;
#undef PG8_SA
#undef PG8_SB
#undef PG8_STAGE
#undef PG8_LDA
#undef PG8_LDB
#undef PG8_MMA
#undef PG8_WAIT_V
#undef PG8_WAIT_L
#undef PG8_BAR
#undef PG8_SCHED
}
}

__device__ void transpose_cvt(LAS unsigned char* lds, const float* __restrict__ src, bf16_t* __restrict__ dst, int R, int C, const float* __restrict__ scale, int G, int bid) {
    LAS float* T = (LAS float*)lds;
    const int tid = opaque_tid(), lane = tid & 63, wid = tid >> 6;
    const int tc = C / 256, nt = (R / 64) * tc;
    for (int t = bid; t < nt; t += G) {
        const int r0 = (t / tc) * 64, c0 = (t % tc) * 256;
        __syncthreads();
#pragma unroll
        for (int i = 0; i < 8; ++i) { const int row = wid + 8 * i; const float sc = scale ? scale[r0 + row] : 1.f;
            const float* sp = src + (size_t)(r0 + row) * C + c0 + lane;
#pragma unroll
            for (int j = 0; j < 4; ++j) T[row * 257 + j * 64 + lane] = sp[j * 64] * sc; }
        __syncthreads();
        const int rp = lane & 31, cs = lane >> 5;
#pragma unroll
        for (int i = 0; i < 16; ++i) { const int cc = wid * 32 + i * 2 + cs;
            const unsigned w = cvt_pk_bf16(T[(2 * rp) * 257 + cc], T[(2 * rp + 1) * 257 + cc]);
            *(unsigned*)(dst + (size_t)(c0 + cc) * R + r0 + 2 * rp) = w; }
    }
}

__device__ void filter_gen(LAS unsigned char* lds, const Args& a, int G, int bid) {
    LAS float* F = (LAS float*)lds;
    LAS float* HA = F + 64 * 33;
    LAS float* HB = HA + 64 * 64;
    const int tid = opaque_tid(), lane = tid & 63, wid = __builtin_amdgcn_readfirstlane(tid >> 6);
    bf16_t* KR = (bf16_t*)(a.ws + WS_KR);
    const float MIN_DECAY = -15.350567286626973f, MAX_DECAY = -3.0701134573253945f;
    for (int it = bid; it < 256; it += G) {
        const int l = it >> 7, tt = (it >> 2) & 31, nc = it & 3;
        const int tlo = tt * 64 + ((nc & 1) ? 0 : 1);
        const float* w1 = a.fw1 + l * 33 * 64; const float* b1 = a.fb1 + l * 64; const float* w2 = a.fw2 + l * 64 * 64; const float* b2 = a.fb2 + l * 64;
        const float* w3 = a.fw3 + l * 64 * 64; const float* b3 = a.fb3 + l * 64; const float* w4 = a.fw4 + (size_t)l * 64 * 4096; const float* fr_ = a.ffreq + l * 64;
        __syncthreads();
        for (int idx = tid; idx < 64 * 33; idx += 512) {
            const int t = idx / 33, j = idx % 33; const int tg = tlo + t; float v;
            if (j == 0) v = (float)tg / (float)(SEQ - 1);
            else { const int bi = (j - 1) & 15; const float band = 1e-4f + (float)bi * ((15.f - 1e-4f) / 15.f);
                const float ang = ((float)(2.0 * 3.14159265358979323846 / SEQ) * (float)tg) * band; v = (j <= 16) ? cos_rr(ang) : -sin_rr(ang); }
            F[idx] = v;
        }
        __syncthreads();
        const int t = tid >> 3, j0 = (tid & 7) * 8;
        {   float s[8];
#pragma unroll
            for (int e = 0; e < 8; ++e) s[e] = b1[j0 + e];
#pragma unroll 11
            for (int k = 0; k < 33; ++k) { const float f = F[t * 33 + k];
#pragma unroll
                for (int e = 0; e < 8; ++e) s[e] += f * w1[k * 64 + j0 + e]; }
#pragma unroll
            for (int e = 0; e < 8; ++e) HA[t * 64 + j0 + e] = sin_rr(fr_[j0 + e] * s[e]);
        }
        __syncthreads();
        {   float s[8];
#pragma unroll
            for (int e = 0; e < 8; ++e) s[e] = b2[j0 + e];
#pragma unroll 16
            for (int k = 0; k < 64; ++k) { const float f = HA[t * 64 + k];
#pragma unroll
                for (int e = 0; e < 8; ++e) s[e] += f * w2[k * 64 + j0 + e]; }
#pragma unroll
            for (int e = 0; e < 8; ++e) HB[t * 64 + j0 + e] = sin_rr(fr_[j0 + e] * s[e]);
        }
        __syncthreads();
        {   float s[8];
#pragma unroll
            for (int e = 0; e < 8; ++e) s[e] = b3[j0 + e];
#pragma unroll 16
            for (int k = 0; k < 64; ++k) { const float f = HB[t * 64 + k];
#pragma unroll
                for (int e = 0; e < 8; ++e) s[e] += f * w3[k * 64 + j0 + e]; }
#pragma unroll
            for (int e = 0; e < 8; ++e) HA[t * 64 + j0 + e] = sin_rr(fr_[j0 + e] * s[e]);
        }
        __syncthreads();
        LAS bf16_t* TT = (LAS bf16_t*)(lds + 49152) + wid * (64 * 66);
#pragma unroll 1
        for (int chunk = 0; chunk < 2; ++chunk) {
            const int n0 = nc * 1024 + wid * 128 + chunk * 64, n = n0 + lane;
            float w[64];
#pragma unroll
            for (int k = 0; k < 64; ++k) w[k] = w4[(size_t)k * 4096 + n];
            const int o = n0 >> 11, dir = (n0 >> 10) & 1, c = n & 1023;
            const float delta = fabsf(MIN_DECAY + (float)c * ((MAX_DECAY - MIN_DECAY) / 1023.f));
#pragma unroll 2
            for (int t2 = 0; t2 < 64; ++t2) {
                float s0 = 0.f;
#pragma unroll
                for (int k4 = 0; k4 < 16; ++k4) { const f32x4 hv = *(const LAS f32x4*)(HA + t2 * 64 + k4 * 4);
                    s0 += hv[0] * w[4 * k4] + hv[1] * w[4 * k4 + 1] + hv[2] * w[4 * k4 + 2] + hv[3] * w[4 * k4 + 3]; }
                const int tg = tlo + t2; const float tn = (float)tg / (float)(SEQ - 1);
                s0 *= expf(-tn * delta);
                if (tg == SEQ) s0 = 0.f;
                TT[lane * 66 + (dir ? t2 : 63 - t2)] = f2bf(s0);
            }
            if (dir == 1 && tt == 0) {
                float sf = 0.f;
#pragma unroll 16
                for (int k = 0; k < 64; ++k) sf += HA[k] * w4[(size_t)k * 4096 + n - 1024];
                TT[lane * 66] = f2bf(sf);
            }
            const int idx0 = dir ? (2048 + tt * 64) : (1984 - tt * 64);
            bf16_t* rowb = KR + ((size_t)((l * 2 + o) * 1024 + (n0 & 1023))) * 4096;
            for (int r = 0; r < 64; ++r) rowb[(size_t)r * 4096 + idx0 + lane] = TT[r * 66 + lane];
        }
    }
}

__device__ void prologue(LAS unsigned char* lds, const Args& a, int G, int bid) {
    unsigned char* ws = a.ws;
    for (int l = 0; l < 2; ++l) {
        transpose_cvt(lds, a.w_in + (size_t)l * DM * NIN, (bf16_t*)(ws + WS_WIN) + (size_t)l * NIN * DM, DM, NIN, a.norm_g + l * DM, G, bid);
        transpose_cvt(lds, a.w_hy + (size_t)l * HW * DM, (bf16_t*)(ws + WS_WH) + (size_t)l * DM * HW, HW, DM, nullptr, G, bid);
        transpose_cvt(lds, a.w_at + (size_t)l * HW * DM, (bf16_t*)(ws + WS_WA) + (size_t)l * DM * HW, HW, DM, nullptr, G, bid);
        transpose_cvt(lds, a.w_out + (size_t)l * DM * DM, (bf16_t*)(ws + WS_WO) + (size_t)l * DM * DM, DM, DM, nullptr, G, bid);
    }
    filter_gen(lds, a, G, bid);
    {
        float* rope = (float*)(ws + WS_ROPE);
        for (int idx = bid * 512 + opaque_tid(); idx < SEQ * 16; idx += G * 512) {
            const int pos = idx >> 4, i = idx & 15;
            const float inv = exp2f(-(float)(2 * i) * (18.931568569324174f / 32.0f)), ang = (float)pos * inv;
            rope[pos * 32 + i] = cos_rr(ang); rope[pos * 32 + 16 + i] = sin_rr(ang);
        }
    }
    {
        float* ssq = (float*)(ws + WS_SSQ); bf16_t* XB = (bf16_t*)(ws + WS_XB);
        const int tid = opaque_tid(), lane = tid & 63, wid = tid >> 6;
        for (int row = bid * 8 + wid; row < MTOK; row += G * 8) {
            const float* xr = a.x + (size_t)row * DM; float ss = 0.f;
#pragma unroll
            for (int i = 0; i < 4; ++i) {
                const f32x4 v0 = *(const f32x4*)(xr + i * 512 + lane * 8), v1 = *(const f32x4*)(xr + i * 512 + lane * 8 + 4);
                ss += (v0[0] * v0[0] + v0[1] * v0[1]) + (v0[2] * v0[2] + v0[3] * v0[3]) + (v1[0] * v1[0] + v1[1] * v1[1]) + (v1[2] * v1[2] + v1[3] * v1[3]);
                u32x4 w; w.x = cvt_pk_bf16(v0[0], v0[1]); w.y = cvt_pk_bf16(v0[2], v0[3]); w.z = cvt_pk_bf16(v1[0], v1[1]); w.w = cvt_pk_bf16(v1[2], v1[3]);
                *(u32x4*)(XB + (size_t)row * DM + i * 512 + lane * 8) = w;
            }
#pragma unroll
            for (int o = 32; o >= 1; o >>= 1) ss += __shfl_xor(ss, o);
            if (lane == 0) { ssq[row] = ss; ssq[MTOK + row] = 0.f; ssq[2 * MTOK + row] = 0.f; }
        }
    }
}

__device__ void ssq_reduce(const Args& a, int bid) {
    const float* ssqp = (const float*)(a.ws + WS_SSQP); float* ssq = (float*)(a.ws + WS_SSQ) + MTOK;
    const int tid = opaque_tid();
    for (int row = bid * 64 + tid; row < MTOK && tid < 64; row += gridDim.x * 64) {
        float s0 = 0.f;
#pragma unroll
        for (int j = 0; j < 8; ++j) { const f32x4 p0 = *(const f32x4*)(ssqp + (size_t)row * 32 + j * 4); s0 += (p0[0] + p0[1]) + (p0[2] + p0[3]); }
        ssq[row] = s0;
    }
}

__device__ void final_norm(const Args& a, int G, int bid, float* dstp) {
    const float* ssqp = (const float*)(a.ws + WS_SSQP);
    const int tid = opaque_tid(), lane = tid & 63, wid = tid >> 6;
    for (int row = (bid * 8 + wid) * 2; row < MTOK; row += G * 16) {
        float s0 = 0.f, s1 = 0.f;
#pragma unroll
        for (int j = 0; j < 8; ++j) { const f32x4 p0 = *(const f32x4*)(ssqp + (size_t)row * 32 + j * 4), p1 = *(const f32x4*)(ssqp + (size_t)(row + 1) * 32 + j * 4);
            s0 += (p0[0] + p0[1]) + (p0[2] + p0[3]); s1 += (p1[0] + p1[1]) + (p1[2] + p1[3]); }
        const float rs0 = __builtin_amdgcn_rsqf(s0 * (1.f / DM) + EPS), rs1 = __builtin_amdgcn_rsqf(s1 * (1.f / DM) + EPS);
        const float* xr = a.out + (size_t)row * DM; float* xw = dstp + (size_t)row * DM;
        f32x4 v[16];
#pragma unroll
        for (int i = 0; i < 16; ++i) v[i] = *(const f32x4*)(xr + i * 256 + lane * 4);
#pragma unroll
        for (int i = 0; i < 16; ++i) { const f32x4 g = *(const f32x4*)(a.fnorm + (i & 7) * 256 + lane * 4);
            *(f32x4*)(xw + i * 256 + lane * 4) = v[i] * (i < 8 ? rs0 : rs1) * g; }
    }
}

constexpr int HY_PITCH = 4112, HY_UB = 0, HY_KR0 = 33024, HY_KRSZ = 8448, HY_YB = 50176;
__device__ __forceinline__ bf16x8 hy_ldA(const LAS unsigned char* kr, int byteoff) {
    const LAS unsigned* p = (const LAS unsigned*)(kr + byteoff);
    u32x4 v; v.x = p[0]; v.y = p[1]; v.z = p[2]; v.w = p[3];
    return __builtin_bit_cast(bf16x8, v);
}
__device__ __forceinline__ bf16x8 hy_ldB(const LAS unsigned char* p, unsigned sh) {
    const u32x4 w = *(const LAS u32x4*)p; const unsigned w4 = *(const LAS unsigned*)(p + 16);
    u32x4 o; o.x = __builtin_amdgcn_alignbit(w.y, w.x, sh); o.y = __builtin_amdgcn_alignbit(w.z, w.y, sh); o.z = __builtin_amdgcn_alignbit(w.w, w.z, sh); o.w = __builtin_amdgcn_alignbit(w4, w.w, sh);
    return __builtin_bit_cast(bf16x8, o);
}
__device__ __forceinline__ void hy_conv(f32x4 (&acc)[8], const LAS unsigned char* kr, const LAS unsigned char* ubrow, int abase, int mi0, unsigned sh) {
#pragma unroll
    for (int q = 0; q < 8; ++q) acc[q] = (f32x4){0.f, 0.f, 0.f, 0.f};
    bf16x8 A[8];
#pragma unroll
    for (int q = 0; q < 8; ++q) A[q] = hy_ldA(kr, abase - 64 * (mi0 + q));
    bf16x8 B = hy_ldB(ubrow, sh);
    for (int k = 0; k < 8; ++k) {
#pragma unroll
        for (int u = 0; u < 8; ++u) {
            const int si = 8 * k + u;
            const bf16x8 Bn = hy_ldB(ubrow + ((si + 1) & 63) * 64, sh);
            const bf16x8 An = hy_ldA(kr, abase - 64 * (mi0 - si - 1));
            __builtin_amdgcn_s_setprio(1);
#pragma unroll
            for (int q = 0; q < 8; ++q) acc[q] = __builtin_amdgcn_mfma_f32_16x16x32_bf16(A[(q - u) & 7], B, acc[q], 0, 0, 0);
            __builtin_amdgcn_s_setprio(0);
            A[(7 - u) & 7] = An; B = Bn;
        }
    }
}
__device__ __forceinline__ f32x4 hy_sc4(const u32x4 ch, float prev, float next, int r, float w0, float w1, float w2, float bs) {
    const float x0 = bflo(ch.x), x1 = bfhi(ch.x), x2 = bflo(ch.y), x3 = bfhi(ch.y), x4 = bflo(ch.z), x5 = bfhi(ch.z), x6 = bflo(ch.w), x7 = bfhi(ch.w);
    f32x4 o;
    o[0] = bs + w0 * (r ? x0 : prev) + w1 * (r ? x1 : x0) + w2 * (r ? x2 : x1);
    o[1] = bs + w0 * (r ? x2 : x1) + w1 * (r ? x3 : x2) + w2 * (r ? x4 : x3);
    o[2] = bs + w0 * (r ? x4 : x3) + w1 * (r ? x5 : x4) + w2 * (r ? x6 : x5);
    o[3] = bs + w0 * (r ? x6 : x5) + w1 * (r ? x7 : x6) + w2 * (r ? next : x7);
    return o;
}
__device__ __forceinline__ f32x4 hy_load_sc4(const bf16_t* rowp, int t0, int r, float w0, float w1, float w2, float bs) {
    const u32x4 ch = *(const u32x4*)(rowp + t0);
    const unsigned pv = rowp[t0 > 0 ? t0 - 1 : 0], nv = rowp[t0 + 8 < SEQ ? t0 + 8 : SEQ - 1];
    const float prev = t0 > 0 ? bf2f(pv) : 0.f, next = (t0 + 8 < SEQ) ? bf2f(nv) : 0.f;
    return hy_sc4(ch, prev, next, r, w0, w1, w2, bs);
}

__device__ void hyena_item(LAS unsigned char* lds, const Args& a, int l, int c4) {
    const bf16_t* UT = (const bf16_t*)(a.ws + WS_UT);
    const bf16_t* KRg = (const bf16_t*)(a.ws + WS_KR);
    bf16_t* YH = (bf16_t*)(a.ws + WS_YH);
    LAS unsigned char* ub = lds + HY_UB;
    const float* cw = a.conv_w + (size_t)l * 3 * 3072; const float* cb = a.conv_b + (size_t)l * 3072;
#pragma unroll 1
    for (int ch = 0; ch < 4; ++ch) {
    const int c = c4 * 4 + ch;
    const int tid = opaque_tid(), lane = tid & 63, wid = __builtin_amdgcn_readfirstlane(tid >> 6), fr = lane & 15, fq = lane >> 4;
    __syncthreads();
#pragma unroll
    for (int o = 0; o < 2; ++o)
        *(LAS u32x4*)(lds + HY_KR0 + o * HY_KRSZ + tid * 16) = *(const u32x4*)(KRg + ((size_t)((l * 2 + o) * 1024 + c)) * 4096 + tid * 8);
    {   const float w0 = cw[c], w1 = cw[3072 + c], w2 = cw[2 * 3072 + c], bs = cb[c];
        const bf16_t* rowp = UT + (size_t)c * MTOK;
#pragma unroll
        for (int i = 0; i < 4; ++i) {
            const int q = tid + 512 * i, b = q >> 8, t0 = (q & 255) * 8;
            const bf16_t* rp = rowp + b * SEQ;
            const f32x4 e0 = hy_load_sc4(rp, t0, 0, w0, w1, w2, bs), e1 = hy_load_sc4(rp, t0, 1, w0, w1, w2, bs);
            u32x4 w; w.x = cvt_pk_bf16(e0[0], e1[0]); w.y = cvt_pk_bf16(e0[1], e1[1]); w.z = cvt_pk_bf16(e0[2], e1[2]); w.w = cvt_pk_bf16(e0[3], e1[3]);
            *(LAS u32x4*)(ub + b * HY_PITCH + t0 * 2) = w;
            if (t0 == SEQ - 8) *(LAS u32x4*)(ub + b * HY_PITCH + SEQ * 2) = (u32x4){0u, 0u, 0u, 0u};
        }
    }
    __syncthreads();
    const int b = fr >> 1, r = fr & 1, mi0 = wid * 8;
    const unsigned sh = 16u * (unsigned)r;
    const int abase = 4096 - 4 * fr + 16 * fq;
    const LAS unsigned char* ubrow = ub + b * HY_PITCH + fq * 16;
    f32x4 acc[8];
    u32x4 pc[8]; unsigned pp[8], pn[8];
    {   const bf16_t* rp = UT + (size_t)(1024 + c) * MTOK + b * SEQ;
#pragma unroll
        for (int q = 0; q < 8; ++q) { const int t0 = 32 * (mi0 + q) + 8 * fq;
            pc[q] = *(const u32x4*)(rp + t0); pp[q] = rp[t0 > 0 ? t0 - 1 : 0]; pn[q] = rp[t0 + 8 < SEQ ? t0 + 8 : SEQ - 1]; }
    }
    hy_conv(acc, lds + HY_KR0, ubrow, abase, mi0, sh);
    const float u0 = bf2f(*(const LAS bf16_t*)(ub + b * HY_PITCH));
    __syncthreads();
    {   const float bias0 = a.hbias[(size_t)(l * 2 + 0) * 1024 + c];
        const float w0 = cw[1024 + c], w1 = cw[3072 + 1024 + c], w2 = cw[2 * 3072 + 1024 + c], bs = cb[1024 + c];
#pragma unroll
        for (int q = 0; q < 8; ++q) {
            const int t0 = 32 * (mi0 + q) + 8 * fq;
            const f32x4 hx1 = hy_sc4(pc[q], t0 > 0 ? bf2f(pp[q]) : 0.f, (t0 + 8 < SEQ) ? bf2f(pn[q]) : 0.f, r, w0, w1, w2, bs);
#pragma unroll
            for (int j = 0; j < 4; ++j) {
                const int t = t0 + 2 * j + r;
                const float hv = bf2f(*(const LAS bf16_t*)(ub + b * HY_PITCH + t * 2));
                float v = acc[q][j] + bias0 * hv;
                if (r) v += bf2f(*(const LAS bf16_t*)(lds + HY_KR0 + (2048 - t) * 2)) * u0;
                acc[q][j] = hx1[j] * v;
            }
        }
    }
    __syncthreads();
#pragma unroll
    for (int q = 0; q < 8; ++q)
#pragma unroll
        for (int j = 0; j < 4; ++j) { const int t = 32 * (mi0 + q) + 8 * fq + 2 * j + r; *(LAS bf16_t*)(ub + b * HY_PITCH + t * 2) = f2bf(acc[q][j]); }
    u32x2 zq[8];
    {   const bf16_t* rp = UT + (size_t)(2048 + c) * MTOK + b * SEQ;
        const bf16_t* zp = UT + (size_t)(3072 + c) * MTOK + b * SEQ;
#pragma unroll
        for (int q = 0; q < 8; ++q) { const int t0 = 32 * (mi0 + q) + 8 * fq;
            pc[q] = *(const u32x4*)(rp + t0); pp[q] = rp[t0 > 0 ? t0 - 1 : 0]; pn[q] = rp[t0 + 8 < SEQ ? t0 + 8 : SEQ - 1];
            const u32x4 zc = *(const u32x4*)(zp + t0);
            zq[q].x = r ? ((zc.x >> 16) | (zc.y & 0xffff0000u)) : ((zc.x & 0xffffu) | (zc.y << 16));
            zq[q].y = r ? ((zc.z >> 16) | (zc.w & 0xffff0000u)) : ((zc.z & 0xffffu) | (zc.w << 16)); }
    }
    __syncthreads();
    if (PROBE_DUP == 10) { hy_conv(acc, lds + HY_KR0 + HY_KRSZ, ubrow, abase, mi0, sh); asm volatile("" :: "v"(acc[0]), "v"(acc[1]), "v"(acc[2]), "v"(acc[3]), "v"(acc[4]), "v"(acc[5]), "v"(acc[6]), "v"(acc[7])); }
    hy_conv(acc, lds + HY_KR0 + HY_KRSZ, ubrow, abase, mi0, sh);
    {   const float z0 = bf2f(*(const LAS bf16_t*)(ub + b * HY_PITCH));
        const float bias1 = a.hbias[(size_t)(l * 2 + 1) * 1024 + c];
        const float w0 = cw[2048 + c], w1 = cw[3072 + 2048 + c], w2 = cw[2 * 3072 + 2048 + c], bs = cb[2048 + c];
#pragma unroll
        for (int q = 0; q < 8; ++q) {
            const int t0 = 32 * (mi0 + q) + 8 * fq;
            const f32x4 hx2 = hy_sc4(pc[q], t0 > 0 ? bf2f(pp[q]) : 0.f, (t0 + 8 < SEQ) ? bf2f(pn[q]) : 0.f, r, w0, w1, w2, bs);
            const float zh[4] = {bflo(zq[q].x), bfhi(zq[q].x), bflo(zq[q].y), bfhi(zq[q].y)};
#pragma unroll
            for (int j = 0; j < 4; ++j) {
                const int t = t0 + 2 * j + r;
                const float z = bf2f(*(const LAS bf16_t*)(ub + b * HY_PITCH + t * 2));
                float v = acc[q][j] + bias1 * z;
                if (r) v += bf2f(*(const LAS bf16_t*)(lds + HY_KR0 + HY_KRSZ + (2048 - t) * 2)) * z0;
                acc[q][j] = hx2[j] * v * zh[j];
            }
        }
    }
    {   unsigned pk[16];
#pragma unroll
        for (int q = 0; q < 8; ++q) { pk[2 * q] = cvt_pk_bf16(acc[q][0], acc[q][1]); pk[2 * q + 1] = cvt_pk_bf16(acc[q][2], acc[q][3]); }
        LAS unsigned char* yb = lds + HY_YB + tid * 16;
        if (ch < 3) {
#pragma unroll
            for (int k = 0; k < 4; ++k) *(LAS u32x4*)(yb + ch * 32768 + k * 8192) = (u32x4){pk[4 * k], pk[4 * k + 1], pk[4 * k + 2], pk[4 * k + 3]};
        } else {
#pragma unroll
            for (int k = 0; k < 4; ++k) {
                const u32x4 p0 = *(const LAS u32x4*)(yb + k * 8192), p1 = *(const LAS u32x4*)(yb + 32768 + k * 8192), p2 = *(const LAS u32x4*)(yb + 65536 + k * 8192);
#pragma unroll
                for (int e = 0; e < 4; ++e) {
                    const int q = 2 * k + (e >> 1), j0 = 2 * (e & 1);
                    const unsigned d0 = p0[e], d1 = p1[e], d2 = p2[e], d3 = pk[4 * k + e];
                    const int t = 32 * (mi0 + q) + 8 * fq + 2 * j0 + r;
                    bf16_t* yp = YH + (size_t)(b * SEQ + t) * HW + c4 * 4;
                    *(u32x2*)yp = (u32x2){(d0 & 0xffffu) | (d1 << 16), (d2 & 0xffffu) | (d3 << 16)};
                    *(u32x2*)(yp + 2 * HW) = (u32x2){(d0 >> 16) | (d1 & 0xffff0000u), (d2 >> 16) | (d3 & 0xffff0000u)};
                }
            }
            asm volatile("s_waitcnt vmcnt(0)" ::: "memory");
        }
    }
    }
}

constexpr int AT_PITCH = 272, AT_KS = 0, AT_VS = 128 * AT_PITCH;
__device__ void attn_item(LAS unsigned char* lds, const Args& a, int l, int item) {
    const int tid = opaque_tid(), lane = tid & 63, wid = __builtin_amdgcn_readfirstlane(tid >> 6), fr = lane & 15, fq = lane >> 4;
    const int hp = item & 3, qb = (item >> 2) & 15, b = item >> 6, kvh = hp >> 1, head = 2 * hp + (wid >> 2), qrow0 = 32 * (wid & 3);
    const bf16_t* Q = (const bf16_t*)(a.ws + WS_Q); const bf16_t* Kg = (const bf16_t*)(a.ws + WS_K); const bf16_t* VT = (const bf16_t*)(a.ws + WS_VT);
    const bf16_t* ZA = (const bf16_t*)(a.ws + WS_ZA); bf16_t* YA = (bf16_t*)(a.ws + WS_YA);
    constexpr float LOG2E = 1.4426950408889634f, SC2 = 0.08838834764831845f * LOG2E;
    bf16x8 qf[2][4];
#pragma unroll
    for (int qt = 0; qt < 2; ++qt)
#pragma unroll
        for (int ks = 0; ks < 4; ++ks)
            qf[qt][ks] = *(const bf16x8*)(Q + (size_t)(b * SEQ + qb * 128 + qrow0 + 16 * qt + fr) * 1024 + head * 128 + 32 * ks + 8 * fq);
    f32x4 O[2][8];
#pragma unroll
    for (int qt = 0; qt < 2; ++qt)
#pragma unroll
        for (int dt = 0; dt < 8; ++dt) O[qt][dt] = (f32x4){0.f, 0.f, 0.f, 0.f};
    const float sink2 = a.sink[l * 8 + head] * LOG2E;
    float mrun[2] = {sink2, sink2}, lsum[2] = {fq == 0 ? 1.f : 0.f, fq == 0 ? 1.f : 0.f};
    for (int rel = -1; rel <= 1; ++rel) {
        const int kt = qb + rel;
        if (kt < 0 || kt > 15) continue;
        __syncthreads();
#pragma unroll
        for (int i = 0; i < 4; ++i) {
            const int q = tid + 512 * i, row = q >> 4, ch = q & 15;
            *(LAS u32x4*)(lds + AT_KS + row * AT_PITCH + ch * 16) = *(const u32x4*)(Kg + (size_t)(b * SEQ + kt * 128 + row) * 256 + kvh * 128 + ch * 8);
            *(LAS u32x4*)(lds + AT_VS + row * AT_PITCH + ch * 16) = *(const u32x4*)(VT + (size_t)(kvh * 128 + row) * MTOK + b * SEQ + kt * 128 + ch * 8);
        }
        __syncthreads();
#pragma unroll
        for (int kh = 0; kh < 2; ++kh) {
            if ((rel < 0 && kh == 0 && qrow0 >= 64) || (rel > 0 && kh == 1 && qrow0 < 64)) continue;
            f32x4 S[2][4];
#pragma unroll
            for (int qt = 0; qt < 2; ++qt)
#pragma unroll
                for (int st = 0; st < 4; ++st) S[qt][st] = (f32x4){0.f, 0.f, 0.f, 0.f};
#pragma unroll
            for (int st = 0; st < 4; ++st)
#pragma unroll
                for (int ks = 0; ks < 4; ++ks) {
                    const bf16x8 kf = *(const LAS bf16x8*)(lds + AT_KS + (64 * kh + 16 * st + fr) * AT_PITCH + (32 * ks + 8 * fq) * 2);
#pragma unroll
                    for (int qt = 0; qt < 2; ++qt) S[qt][st] = __builtin_amdgcn_mfma_f32_16x16x32_bf16(kf, qf[qt][ks], S[qt][st], 0, 0, 0);
                }
            bf16x8 pf[2][2];
#pragma unroll
            for (int qt = 0; qt < 2; ++qt) {
                const int qq = qrow0 + 16 * qt + fr;
                float mx = -INFINITY;
#pragma unroll
                for (int st = 0; st < 4; ++st)
#pragma unroll
                    for (int j = 0; j < 4; ++j) {
                        const int kk = 64 * kh + 16 * st + 4 * fq + j;
                        const bool valid = (rel == 0) || (rel < 0 ? (kk >= qq) : (kk <= qq));
                        const float s = valid ? S[qt][st][j] * SC2 : -INFINITY;
                        S[qt][st][j] = s; mx = fmaxf(mx, s);
                    }
                mx = fmaxf(mx, __shfl_xor(mx, 16)); mx = fmaxf(mx, __shfl_xor(mx, 32));
                const float mnew = fmaxf(mrun[qt], mx), alpha = __builtin_amdgcn_exp2f(mrun[qt] - mnew);
                mrun[qt] = mnew;
                float ps = 0.f;
#pragma unroll
                for (int st = 0; st < 4; ++st)
#pragma unroll
                    for (int j = 0; j < 4; ++j) { const float p = __builtin_amdgcn_exp2f(S[qt][st][j] - mnew); S[qt][st][j] = p; ps += p; }
                lsum[qt] = lsum[qt] * alpha + ps;
#pragma unroll
                for (int dt = 0; dt < 8; ++dt) O[qt][dt] = O[qt][dt] * alpha;
#pragma unroll
                for (int kp = 0; kp < 2; ++kp) {
                    u32x4 w; w.x = cvt_pk_bf16(S[qt][2 * kp][0], S[qt][2 * kp][1]); w.y = cvt_pk_bf16(S[qt][2 * kp][2], S[qt][2 * kp][3]);
                    w.z = cvt_pk_bf16(S[qt][2 * kp + 1][0], S[qt][2 * kp + 1][1]); w.w = cvt_pk_bf16(S[qt][2 * kp + 1][2], S[qt][2 * kp + 1][3]);
                    pf[qt][kp] = __builtin_bit_cast(bf16x8, w);
                }
            }
#pragma unroll
            for (int kp = 0; kp < 2; ++kp)
#pragma unroll
                for (int dt = 0; dt < 8; ++dt) {
                    const LAS unsigned char* vp = lds + AT_VS + (16 * dt + fr) * AT_PITCH + (64 * kh + 32 * kp + 4 * fq) * 2;
                    const u32x2 v0 = *(const LAS u32x2*)vp, v1 = *(const LAS u32x2*)(vp + 32);
                    const u32x4 vv = {v0.x, v0.y, v1.x, v1.y};
                    const bf16x8 vf = __builtin_bit_cast(bf16x8, vv);
#pragma unroll
                    for (int qt = 0; qt < 2; ++qt) O[qt][dt] = __builtin_amdgcn_mfma_f32_16x16x32_bf16(vf, pf[qt][kp], O[qt][dt], 0, 0, 0);
                }
        }
    }
#pragma unroll
    for (int qt = 0; qt < 2; ++qt) {
        float ls = lsum[qt]; ls += __shfl_xor(ls, 16); ls += __shfl_xor(ls, 32);
        const float inv = 1.f / ls;
        const size_t rowoff = (size_t)(b * SEQ + qb * 128 + qrow0 + 16 * qt + fr) * 1024 + head * 128 + 4 * fq;
        u32x2 zv[8];
#pragma unroll
        for (int dt = 0; dt < 8; ++dt) zv[dt] = *(const u32x2*)(ZA + rowoff + 16 * dt);
        asm volatile("s_waitcnt vmcnt(0)" ::: "memory");
#pragma unroll
        for (int dt = 0; dt < 8; ++dt) {
            const u32x2 z = zv[dt];
            const f32x4 o = O[qt][dt] * inv;
            u32x2 w; w.x = cvt_pk_bf16(o[0] * bflo(z.x), o[1] * bfhi(z.x)); w.y = cvt_pk_bf16(o[2] * bflo(z.y), o[3] * bfhi(z.y));
            *(u32x2*)(YA + rowoff + 16 * dt) = w;
        }
        asm volatile("s_waitcnt vmcnt(0)" ::: "memory");
    }
}

__device__ void mix_phase(LAS unsigned char* lds, const Args& a, int l, int G, int bid) {
    const int vcu = (G % 8 == 0) ? (bid % 8) * (G / 8) + bid / 8 : bid;
    for (int it = vcu; it < 256 + 512; it += G) {
        if (it < 256) { hyena_item(lds, a, l, it); if (PROBE_DUP == 8) hyena_item(lds, a, l, it); }
        else { attn_item(lds, a, l, it - 256); if (PROBE_DUP == 9) attn_item(lds, a, l, it - 256); }
    }
    __syncthreads();
}


#define XB_TMO      128
#define XB_XCNT(j)  (256  + 64 * (j))
#define XB_XSUB(j)  (1280 + 64 * (j))
#define XB_XGEN(j)  (2304 + 64 * (j))
#define XB_TOP      3328
#define XB_TOPGEN   3392
#define XCD_BAR_WORDS 3456
#define XB_SPIN_CAP (1u << 21)
__device__ __forceinline__ unsigned xb_ld(unsigned* p)              { return __hip_atomic_load(p, __ATOMIC_RELAXED, __HIP_MEMORY_SCOPE_AGENT); }
__device__ __forceinline__ unsigned xb_add(unsigned* p, unsigned v) { return __hip_atomic_fetch_add(p, v, __ATOMIC_RELAXED, __HIP_MEMORY_SCOPE_AGENT); }
__device__ __forceinline__ unsigned xb_xcc_id() { return (unsigned)__builtin_amdgcn_s_getreg((3 << 11) | 20) & 0xFu; }
#define XB_SPIN(cond, bar) do { unsigned _sp = 0; while (cond) { __builtin_amdgcn_s_sleep(1); \
    if ((++_sp & 255u) == 0u) { if (xb_ld(&(bar)[XB_TMO])) break; if (_sp > XB_SPIN_CAP) { atomicAdd(&(bar)[XB_TMO], 1u); break; } } } } while (0)
struct XcdBarrier { unsigned* bar; unsigned x; volatile LAS unsigned* st; };
__device__ __forceinline__ XcdBarrier xcd_barrier_post(unsigned* bar, volatile LAS unsigned* st) {
    XcdBarrier b; b.bar = bar; b.x = xb_xcc_id(); b.st = st;
    if (threadIdx.x == 0) (void)xb_add(&bar[XB_XCNT(b.x)], 1u);
    return b;
}
__device__ __forceinline__ void xcd_barrier_complete(unsigned* bar, unsigned x, unsigned& nloc, unsigned& nx) {
    const unsigned G = gridDim.x * gridDim.y * gridDim.z;
    unsigned sum, cnt, mine, sp = 0u;
    for (;;) {
        sum = 0u; cnt = 0u; mine = 0u;
#pragma unroll
        for (unsigned j = 0; j < 16; ++j) { const unsigned c = xb_ld(&bar[XB_XCNT(j)]); sum += c; cnt += (c > 0u) ? 1u : 0u; mine = (j == x) ? c : mine; }
        if (sum == G) break;
        __builtin_amdgcn_s_sleep(1);
        if ((++sp & 255u) == 0u) { if (xb_ld(&bar[XB_TMO])) break; if (sp > XB_SPIN_CAP) { atomicAdd(&bar[XB_TMO], 1u); break; } }
    }
    nloc = mine > 0u ? mine : 1u; nx = cnt > 0u ? cnt : 1u;
}
__device__ __forceinline__ void xcd_barrier(const XcdBarrier& b) {
    asm volatile("s_waitcnt vmcnt(0)" ::: "memory");
    __syncthreads();
    if (threadIdx.x == 0) {
        unsigned* bar = b.bar;
        __builtin_amdgcn_s_waitcnt(0);
        unsigned nloc = b.st[0], nx = b.st[1];
        if (nloc == 0u) { xcd_barrier_complete(bar, b.x, nloc, nx); b.st[0] = nloc; b.st[1] = nx; }
        const unsigned old = xb_add(&bar[XB_XSUB(b.x)], 1u);
        const unsigned gen = old / nloc;
        if (old + 1u == (gen + 1u) * nloc) {
            __builtin_amdgcn_fence(__ATOMIC_RELEASE, "agent");
            asm volatile("s_waitcnt vmcnt(0)" ::: "memory");
            const unsigned og = xb_add(&bar[XB_TOP], 1u);
            const unsigned tg = og / nx;
            if (og + 1u == (tg + 1u) * nx) xb_add(&bar[XB_TOPGEN], 1u);
            else XB_SPIN(xb_ld(&bar[XB_TOPGEN]) == tg, bar);
            __builtin_amdgcn_fence(__ATOMIC_ACQUIRE, "agent");
            xb_add(&bar[XB_XGEN(b.x)], 1u);
            asm volatile("s_waitcnt vmcnt(0)" ::: "memory");
        } else {
            XB_SPIN(xb_ld(&bar[XB_XGEN(b.x)]) == gen, bar);
            __builtin_amdgcn_fence(__ATOMIC_ACQUIRE, "agent");
            asm volatile("s_waitcnt vmcnt(0)" ::: "memory");
        }
    }
    __syncthreads();
}

__global__ void __launch_bounds__(512, 2) hybrid_fwd(Args a) {
    extern __shared__ __attribute__((aligned(16))) unsigned char lds_raw[];
    LAS unsigned char* lds = (LAS unsigned char*)lds_raw;
    const int G = gridDim.x, bid = blockIdx.x;
    unsigned char* ws = a.ws;
    {   volatile LAS unsigned* st0 = (volatile LAS unsigned*)(lds + LDS_ST); if (threadIdx.x < 2) st0[threadIdx.x] = 0u; }
    __syncthreads();
    XcdBarrier xbar = xcd_barrier_post((unsigned*)(ws + WS_BAR), (volatile LAS unsigned*)(lds + LDS_ST));
    if (a.ph_lo < 0) cg::this_grid().sync();
    bool redo = false;
    for (int ph = a.ph_lo; ph < a.ph_hi; ++ph) {
        bool sync_after = true;
        const int l = (ph < 6) ? 0 : 1, k = (ph < 6) ? ph - 1 : ph - 7;
        const int kind = (ph == 0) ? 1 : (ph == NPHASE - 1) ? 6 : (ph == 6) ? 11 : (k == 0) ? 2 : (k == 1) ? 3 : (k == 4) ? 5 : 4;
        const int nrep = (PROBE_DUP != 0 && PROBE_DUP != 4 && PROBE_DUP == kind) ? 2 : 1;
        for (int rep = 0; rep < nrep; ++rep) {
        if (ph == 0) prologue(lds, a, G, bid);
        else if (ph == 6) ssq_reduce(a, bid);
        else if (ph == NPHASE - 1) { final_norm(a, G, bid, (PROBE_DUP == 6 && rep == 0) ? (float*)(ws + WS_UT) : a.out); sync_after = false; }
        else {
            if (k == 1) mix_phase(lds, a, l, G, bid);
            else {
                pg8::Sched S; pg8::Epi E;
                E.l = l; E.ws = ws; E.xold = (l == 0) ? a.x : a.out; E.noss = (rep + 1 < nrep); E.xnew = (PROBE_DUP == 5 && E.noss) ? (float*)(ws + WS_GH) : a.out;
                if (k == 0) { E.mode = 0; S.init(0, NIN, DM, ws + WS_XB, (bf16_t*)(ws + WS_WIN) + (size_t)l * NIN * DM); }
                else if (k == 2) { E.mode = 1; S.init(1, DM, HW, ws + WS_YH, (bf16_t*)(ws + WS_WH) + (size_t)l * DM * HW); sync_after = false; }
                else if (k == 3) { E.mode = 2; S.init(1, DM, HW, ws + WS_YA, (bf16_t*)(ws + WS_WA) + (size_t)l * DM * HW); }
                else { E.mode = 3; S.init(1, DM, DM, ws + WS_MG, (bf16_t*)(ws + WS_WO) + (size_t)l * DM * DM); }
                pg8::gemm_phase(lds, S, E);
            }
        }
        }
        if (PROBE_DUP == 4 && kind == 4 && k == 3) { if (!redo) { redo = true; ph -= 2; continue; } redo = false; }
        if (sync_after && ph + 1 < a.ph_hi) { xcd_barrier(xbar); if (PROBE_DUP == 7) xcd_barrier(xbar); }
    }
}

extern "C" void kernel_launch(void* const* d_in, const int* in_sizes, int n_in, void* d_out, int out_size, void* d_ws, size_t ws_size, hipStream_t stream) {
    static int grid = 0;
    if (grid == 0) {
        if (n_in != 19 || out_size != MTOK * DM || ws_size < WS_END) { fprintf(stderr, "kernel_launch: unexpected shapes (n_in %d out %d ws %zu)\n", n_in, out_size, ws_size); grid = -1; return; }
        int dev = 0, cus = 0, per_cu = 0;
        hipGetDevice(&dev); hipDeviceGetAttribute(&cus, hipDeviceAttributeMultiprocessorCount, dev);
        if (hipFuncSetAttribute((const void*)hybrid_fwd, hipFuncAttributeMaxDynamicSharedMemorySize, LDS_BYTES) != hipSuccess) { fprintf(stderr, "kernel_launch: hipFuncSetAttribute failed\n"); grid = -1; return; }
        if (hipOccupancyMaxActiveBlocksPerMultiprocessor(&per_cu, (const void*)hybrid_fwd, 512, LDS_BYTES) != hipSuccess || per_cu < 1) { fprintf(stderr, "kernel_launch: occupancy query gave %d\n", per_cu); per_cu = 1; }
        (void)hipGetLastError();
        grid = cus * 1;
        if (grid <= 0) grid = 256;
    }
    if (grid < 0) return;
    if (hipMemsetAsync((char*)d_ws + WS_BAR, 0, 16384, stream) != hipSuccess) { fprintf(stderr, "kernel_launch: memset of barrier words failed\n"); return; }
    Args a{};
    const float** slots = (const float**)&a;
    for (int i = 0; i < 19; ++i) slots[i] = (const float*)d_in[i];
    a.out = (float*)d_out; a.ws = (unsigned char*)d_ws;
#if MK_MULTI
    for (int ph = 0; ph < NPHASE; ++ph) { a.ph_lo = ph; a.ph_hi = ph + 1; hipLaunchKernelGGL(hybrid_fwd, dim3(grid), dim3(512), LDS_BYTES, stream, a); }
#else
    a.ph_lo = 0; a.ph_hi = NPHASE;
    void* args[] = {&a};
    hipError_t e = hipLaunchCooperativeKernel((const void*)hybrid_fwd, dim3(grid), dim3(512), args, LDS_BYTES, stream);
    if (e != hipSuccess) fprintf(stderr, "cooperative launch failed: %s (grid %d)\n", hipGetErrorString(e), grid);
#endif
}
```

```cpp
#include <hip/hip_runtime.h>
#include <hip/hip_cooperative_groups.h>
#include <cstdio>
#include <cstdint>
namespace cg = cooperative_groups;

#define LAS __attribute__((address_space(3)))
typedef unsigned short bf16_t;
typedef short bf16x8 __attribute__((ext_vector_type(8)));
typedef float f32x4 __attribute__((ext_vector_type(4)));
typedef unsigned u32x4 __attribute__((ext_vector_type(4)));
typedef unsigned u32x2 __attribute__((ext_vector_type(2)));

#ifndef PROBE_DUP
#define PROBE_DUP 0
#endif
#ifndef MK_MULTI
#define MK_MULTI 0
#endif

constexpr int SEQ = 2048, DM = 2048, NB = 8, MTOK = NB * SEQ, NIN = 10752, HW = 1024;
constexpr float EPS = 1e-6f;
constexpr size_t MiB = 1u << 20;
constexpr size_t WS_WIN = 0, WS_WH = 84 * MiB, WS_WA = 92 * MiB, WS_WO = 100 * MiB, WS_KR = 116 * MiB, WS_ROPE = 148 * MiB, WS_SSQ = 148 * MiB + 512 * 1024,
                 WS_BAR = 149 * MiB, WS_XB = 150 * MiB, WS_UT = 214 * MiB, WS_MG = 214 * MiB, WS_VT = 342 * MiB, WS_Q = 350 * MiB, WS_K = 382 * MiB, WS_ZA = 390 * MiB,
                 WS_GH = 422 * MiB, WS_GA = 486 * MiB, WS_YH = 550 * MiB, WS_YA = 582 * MiB, WS_SSQP = 614 * MiB, WS_END = 616 * MiB;
constexpr int LDS_BYTES = 149504, LDS_ST = 148544;
constexpr int NPHASE = 13;

struct Args {
    const float* x; const float* norm_g; const float* w_in; const float* conv_w; const float* conv_b;
    const float* fw1; const float* fb1; const float* fw2; const float* fb2; const float* fw3; const float* fb3; const float* fw4; const float* ffreq;
    const float* hbias; const float* sink; const float* w_hy; const float* w_at; const float* w_out; const float* fnorm;
    float* out; unsigned char* ws; int ph_lo, ph_hi;
};

__device__ __forceinline__ unsigned cvt_pk_bf16(float lo, float hi) { unsigned r; asm("v_cvt_pk_bf16_f32 %0, %1, %2" : "=v"(r) : "v"(lo), "v"(hi)); return r; }
__device__ __forceinline__ bf16_t f2bf(float v) { return (bf16_t)(cvt_pk_bf16(v, 0.f) & 0xffffu); }
__device__ __forceinline__ float bf2f(unsigned h) { return __uint_as_float(h << 16); }
__device__ __forceinline__ float bflo(unsigned w) { return __uint_as_float(w << 16); }
__device__ __forceinline__ float bfhi(unsigned w) { return __uint_as_float(w & 0xffff0000u); }
__device__ __forceinline__ int opaque_tid() { int t; asm volatile("v_mov_b32 %0, %1" : "=v"(t) : "v"(threadIdx.x)); return t; }
__device__ __forceinline__ float sin_rr(float x) { double r = (double)x * 0.15915494309189535; r -= rint(r); return __builtin_amdgcn_sinf((float)r); }
__device__ __forceinline__ float cos_rr(float x) { double r = (double)x * 0.15915494309189535; r -= rint(r); return __builtin_amdgcn_cosf((float)r); }
__device__ __forceinline__ float sigmoidf_(float x) { return __builtin_amdgcn_rcpf(1.f + __expf(-x)); }
__device__ __forceinline__ float siluf_(float x) { return x * sigmoidf_(x); }

namespace pg8 {
constexpr int BM = 256, BK = 64, HALF = 128, HTB = HALF * BK * 2, NXCD = 8, WGM = 8;
__host__ __device__ __forceinline__ int lds_byte(int r, int c) { const int st = (r >> 4) * 2 + (c >> 5), rr = r & 15, cc = c & 31, ob = rr * 64 + cc * 2; return st * 1024 + (ob ^ (((ob >> 9) & 1) << 5)); }
__host__ __device__ __forceinline__ void stage_rc(int b, int& R, int& C) { const int st = b / 1024, sb = b % 1024, swz = sb ^ (((sb >> 9) & 1) << 5); R = (st >> 1) * 16 + swz / 64; C = (st & 1) * 32 + (swz % 64) / 2; }
__host__ __device__ __forceinline__ int perm32(int rho) { const int n = rho >> 4, i = rho & 15; return 8 * (i >> 2) + 4 * n + (i & 3); }

struct Unit { const char* a; const char* b; int pm, pn; };

struct Sched {
    int mode, nN, K; const char* A; const char* B;
    __device__ __forceinline__ void init(int mode_, int N, int K_, const void* A_, const void* B_) { mode = mode_; nN = N / BM; K = K_; A = (const char*)A_; B = (const char*)B_; }
    __device__ __forceinline__ bool next(int i, Unit& u) const {
        const int nM = MTOK / BM, nwg = nM * nN, G = gridDim.x;
        const long L = (long)i * G + blockIdx.x; if (L >= nwg) return false;
        int wgid = (int)L; { const int q = nwg / NXCD, r = nwg % NXCD, xcd = wgid % NXCD, off = wgid / NXCD; wgid = (xcd < r ? xcd * (q + 1) : r * (q + 1) + (xcd - r) * q) + off; }
        const int nig = WGM * nN, gid = wgid / nig, fm = gid * WGM, gsz = (nM - fm) < WGM ? (nM - fm) : WGM;
        u.pm = fm + ((wgid % nig) % gsz); u.pn = (wgid % nig) / gsz;
        const bool tr = (mode == 0) && (u.pn < 16 || u.pn == 21);
        const size_t tstep = (size_t)BM * K * 2;
        const char* pa = A + (size_t)u.pm * tstep; const char* pb = B + (size_t)u.pn * tstep;
        u.a = tr ? pb : pa; u.b = tr ? pa : pb; return true;
    }
};

struct Epi {
    int mode, l;
    unsigned char* ws; const float* xold; float* xnew; int noss;

    __device__ __forceinline__ void operator()(const f32x4 (&acc)[2][2][4][2], const Unit& u) const {
        int tid_; asm volatile("v_mov_b32 %0, %1" : "=v"(tid_) : "v"(threadIdx.x));
        const int wid_ = tid_ >> 6, lane_ = tid_ & 63, wr = wid_ >> 2, wc = wid_ & 3, fr = lane_ & 15, fq = lane_ >> 4;
        const int rloc0 = wr * 64 + fr, cloc0 = wc * 32 + 8 * fq;
        if (mode == 0) {
            const float* ssq = (const float*)(ws + WS_SSQ) + (size_t)l * MTOK;
            if (u.pn < 16 || u.pn == 21) {
                bf16_t* base = (u.pn == 21) ? (bf16_t*)(ws + WS_VT) : ((bf16_t*)(ws + WS_UT) + (size_t)u.pn * 256 * MTOK);
                const bool act = (u.pn >= 12 && u.pn < 16);
                const int tok0 = u.pm * 256 + cloc0;
                f32x4 rr[2][2];
#pragma unroll
                for (int bj = 0; bj < 2; ++bj) { rr[bj][0] = *(const f32x4*)(ssq + tok0 + bj * HALF); rr[bj][1] = *(const f32x4*)(ssq + tok0 + bj * HALF + 4); }
                asm volatile("s_waitcnt vmcnt(0)" ::: "memory");
#pragma unroll
                for (int bj = 0; bj < 2; ++bj)
#pragma unroll
                    for (int h = 0; h < 2; ++h)
#pragma unroll
                        for (int e = 0; e < 4; ++e) rr[bj][h][e] = __builtin_amdgcn_rsqf(rr[bj][h][e] * (1.f / DM) + EPS);
#pragma unroll
                for (int bj = 0; bj < 2; ++bj)
#pragma unroll
                    for (int ai = 0; ai < 2; ++ai)
#pragma unroll
                        for (int m = 0; m < 4; ++m) {
                            f32x4 v0 = acc[ai][bj][m][0] * rr[bj][0], v1 = acc[ai][bj][m][1] * rr[bj][1];
                            if (act) {
#pragma unroll
                                for (int e = 0; e < 4; ++e) { v0[e] = siluf_(v0[e]); v1[e] = siluf_(v1[e]); } }
                            u32x4 w; w.x = cvt_pk_bf16(v0[0], v0[1]); w.y = cvt_pk_bf16(v0[2], v0[3]); w.z = cvt_pk_bf16(v1[0], v1[1]); w.w = cvt_pk_bf16(v1[2], v1[3]);
                            *(u32x4*)(base + (size_t)(rloc0 + ai * HALF + m * 16) * MTOK + tok0 + bj * HALF) = w;
                        }
            } else {
                const int pn = u.pn; bf16_t* base; int ld; int act;
                if (pn < 20) { base = (bf16_t*)(ws + WS_Q) + (pn - 16) * 256; ld = 1024; act = 1; }
                else if (pn == 20) { base = (bf16_t*)(ws + WS_K); ld = 256; act = 1; }
                else if (pn < 26) { base = (bf16_t*)(ws + WS_ZA) + (pn - 22) * 256; ld = 1024; act = 2; }
                else if (pn < 34) { base = (bf16_t*)(ws + WS_GH) + (pn - 26) * 256; ld = 2048; act = 3; }
                else { base = (bf16_t*)(ws + WS_GA) + (pn - 34) * 256; ld = 2048; act = 3; }
                const float* rope = (const float*)(ws + WS_ROPE);
                float rsv[8];
#pragma unroll
                for (int it = 0; it < 8; ++it) rsv[it] = ssq[u.pm * 256 + rloc0 + (it >> 2) * HALF + (it & 3) * 16];
                asm volatile("s_waitcnt vmcnt(0)" ::: "memory");
#pragma unroll
                for (int it = 0; it < 8; ++it) rsv[it] = __builtin_amdgcn_rsqf(rsv[it] * (1.f / DM) + EPS);
#pragma unroll
                for (int ai = 0; ai < 2; ++ai)
#pragma unroll
                    for (int m = 0; m < 4; ++m) {
                        const int row = u.pm * 256 + rloc0 + ai * HALF + m * 16;
                        const float rs = rsv[ai * 4 + m];
                        f32x4 c0 = {1.f, 1.f, 1.f, 1.f}, c1 = c0, sn0 = {0.f, 0.f, 0.f, 0.f}, sn1 = sn0;
                        if (act == 1 && wc == 0) { const float* rp = rope + (size_t)(row & (SEQ - 1)) * 32 + 8 * (fq & 1);
                            c0 = *(const f32x4*)rp; c1 = *(const f32x4*)(rp + 4); sn0 = *(const f32x4*)(rp + 16); sn1 = *(const f32x4*)(rp + 20);
                            asm volatile("s_waitcnt vmcnt(0)" ::: "memory");
                            if (fq < 2) { sn0 = -sn0; sn1 = -sn1; } }
#pragma unroll
                        for (int bj = 0; bj < 2; ++bj) {
                            f32x4 v0 = acc[ai][bj][m][0] * rs, v1 = acc[ai][bj][m][1] * rs;
                            if (act == 1) {
                                if (wc == 0) {
                                    f32x4 p0, p1;
#pragma unroll
                                    for (int e = 0; e < 4; ++e) { p0[e] = __shfl_xor(v0[e], 32); p1[e] = __shfl_xor(v1[e], 32); }
                                    v0 = v0 * c0 + p0 * sn0; v1 = v1 * c1 + p1 * sn1;
                                }
                            } else if (act == 2) {
#pragma unroll
                                for (int e = 0; e < 4; ++e) { v0[e] = siluf_(v0[e]); v1[e] = siluf_(v1[e]); }
                            } else if (act == 3) {
#pragma unroll
                                for (int e = 0; e < 4; ++e) { v0[e] = sigmoidf_(v0[e]); v1[e] = sigmoidf_(v1[e]); }
                            }
                            u32x4 w; w.x = cvt_pk_bf16(v0[0], v0[1]); w.y = cvt_pk_bf16(v0[2], v0[3]); w.z = cvt_pk_bf16(v1[0], v1[1]); w.w = cvt_pk_bf16(v1[2], v1[3]);
                            *(u32x4*)(base + (size_t)row * ld + cloc0 + bj * HALF) = w;
                        }
                        if (act == 1) asm volatile("" ::: "memory");
                    }
            }
        } else if (mode == 1 || mode == 2) {
            bf16_t* MG = (bf16_t*)(ws + WS_MG); const bf16_t* G = (const bf16_t*)(ws + (mode == 1 ? WS_GH : WS_GA));
            const size_t off0 = (size_t)(u.pm * 256 + rloc0) * DM + u.pn * 256 + cloc0;
#define EPI_ROWOFF(it) (off0 + (size_t)(((it) >> 2) * HALF + ((it) & 3) * 16) * DM)
#pragma unroll
            for (int ai = 0; ai < 2; ++ai) {
                u32x4 gb[4][2], pb[4][2];
#pragma unroll
                for (int m = 0; m < 4; ++m)
#pragma unroll
                    for (int bj = 0; bj < 2; ++bj) { gb[m][bj] = *(const u32x4*)(G + EPI_ROWOFF(ai * 4 + m) + bj * HALF); if (mode == 2) pb[m][bj] = *(const u32x4*)(MG + EPI_ROWOFF(ai * 4 + m) + bj * HALF); }
                asm volatile("s_waitcnt vmcnt(0)" ::: "memory");
#pragma unroll
                for (int m = 0; m < 4; ++m)
#pragma unroll
                    for (int bj = 0; bj < 2; ++bj) {
                        const u32x4 g = gb[m][bj];
                        f32x4 v0 = acc[ai][bj][m][0], v1 = acc[ai][bj][m][1];
                        v0[0] *= bflo(g.x); v0[1] *= bfhi(g.x); v0[2] *= bflo(g.y); v0[3] *= bfhi(g.y);
                        v1[0] *= bflo(g.z); v1[1] *= bfhi(g.z); v1[2] *= bflo(g.w); v1[3] *= bfhi(g.w);
                        if (mode == 2) { const u32x4 p = pb[m][bj];
                            v0[0] += bflo(p.x); v0[1] += bfhi(p.x); v0[2] += bflo(p.y); v0[3] += bfhi(p.y);
                            v1[0] += bflo(p.z); v1[1] += bfhi(p.z); v1[2] += bflo(p.w); v1[3] += bfhi(p.w); }
                        u32x4 w; w.x = cvt_pk_bf16(v0[0], v0[1]); w.y = cvt_pk_bf16(v0[2], v0[3]); w.z = cvt_pk_bf16(v1[0], v1[1]); w.w = cvt_pk_bf16(v1[2], v1[3]);
                        *(u32x4*)(MG + EPI_ROWOFF(ai * 4 + m) + bj * HALF) = w;
                    }
                asm volatile("s_waitcnt vmcnt(0)" ::: "memory");
            }
        } else {
            bf16_t* XB = (bf16_t*)(ws + WS_XB); float* ssqp = (float*)(ws + WS_SSQP);
            const size_t off0 = (size_t)(u.pm * 256 + rloc0) * DM + u.pn * 256 + cloc0;
#pragma unroll
            for (int ai = 0; ai < 2; ++ai) {
                f32x4 xb[4][2][2];
#pragma unroll
                for (int m = 0; m < 4; ++m)
#pragma unroll
                    for (int bj = 0; bj < 2; ++bj) { xb[m][bj][0] = *(const f32x4*)(xold + EPI_ROWOFF(ai * 4 + m) + bj * HALF); xb[m][bj][1] = *(const f32x4*)(xold + EPI_ROWOFF(ai * 4 + m) + bj * HALF + 4); }
                asm volatile("s_waitcnt vmcnt(0)" ::: "memory");
#pragma unroll
                for (int m = 0; m < 4; ++m) {
                    const int row = u.pm * 256 + rloc0 + ai * HALF + m * 16;
                    const size_t off = EPI_ROWOFF(ai * 4 + m);
                    float ss = 0.f;
#pragma unroll
                    for (int bj = 0; bj < 2; ++bj) {
                        const f32x4 v0 = acc[ai][bj][m][0] + xb[m][bj][0], v1 = acc[ai][bj][m][1] + xb[m][bj][1];
                        *(f32x4*)(xnew + off + bj * HALF) = v0; *(f32x4*)(xnew + off + bj * HALF + 4) = v1;
                        u32x4 w; w.x = cvt_pk_bf16(v0[0], v0[1]); w.y = cvt_pk_bf16(v0[2], v0[3]); w.z = cvt_pk_bf16(v1[0], v1[1]); w.w = cvt_pk_bf16(v1[2], v1[3]);
                        if (l == 0) *(u32x4*)(XB + off + bj * HALF) = w;
                        ss += (v0[0] * v0[0] + v0[1] * v0[1]) + (v0[2] * v0[2] + v0[3] * v0[3]) + (v1[0] * v1[0] + v1[1] * v1[1]) + (v1[2] * v1[2] + v1[3] * v1[3]);
                    }
                    ss += __shfl_xor(ss, 16); ss += __shfl_xor(ss, 32);
                    if (fq == 0) ssqp[(size_t)row * 32 + u.pn * 4 + wc] = ss;
                }
                asm volatile("s_waitcnt vmcnt(0)" ::: "memory");
            }
#undef EPI_ROWOFF
        }
        asm volatile("s_waitcnt vmcnt(0)" ::: "memory");
    }
};

__device__ __forceinline__ void gemm_phase(LAS unsigned char* lds, const Sched& S, const Epi& E) {
    const int K = S.K;
    const int tid = opaque_tid(), wid = __builtin_amdgcn_readfirstlane(tid >> 6), lane = tid & 63, wr = wid >> 2, wc = wid & 3, fr = lane & 15, fq = lane >> 4;
    const int nt = K / BK;
    unsigned voffA[2], voffB[2];
#pragma unroll
    for (int i = 0; i < 2; ++i) { int R, C; stage_rc(tid * 16 + i * 8192, R, C); const int Rb = (R & ~31) + perm32(R & 31);
        voffA[i] = (unsigned)(R * K + C) * 2u; voffB[i] = (unsigned)(Rb * K + C) * 2u; }
    const size_t kstep = (size_t)(BK * 2);
    const size_t hstep = (size_t)HALF * K * 2;
    const unsigned ldsw = (unsigned)wid * 1024u;
    const int aoff = lds_byte(wr * 64 + fr, fq * 8), boff = lds_byte(wc * 32 + fr, fq * 8);
#define PG8_SA(b, h) (((b) * 2 + (h)) * HTB)
#define PG8_SB(b, h) ((4 + (b) * 2 + (h)) * HTB)
#define PG8_STAGE(bufoff, gbase, voff) do { _Pragma("unroll") for (int _i = 0; _i < 2; ++_i) \
        __builtin_amdgcn_global_load_lds((const unsigned*)((const char*)(gbase) + (voff)[_i]), (LAS unsigned*)(lds + (bufoff) + ldsw + _i * 8192), 16, 0, 0); } while (0)
#define PG8_LDA(dst, b, h) do { _Pragma("unroll") for (int m = 0; m < 4; ++m) _Pragma("unroll") for (int k = 0; k < 2; ++k) dst[m][k] = *(const LAS bf16x8*)(lds + PG8_SA(b, h) + aoff + m * 2048 + k * 1024); } while (0)
#define PG8_LDB(dst, b, h) do { _Pragma("unroll") for (int n = 0; n < 2; ++n) _Pragma("unroll") for (int k = 0; k < 2; ++k) dst[n][k] = *(const LAS bf16x8*)(lds + PG8_SB(b, h) + boff + n * 2048 + k * 1024); } while (0)
#define PG8_MMA(ai, bj, At, Bt) do { __builtin_amdgcn_s_setprio(1); _Pragma("unroll") for (int m = 0; m < 4; ++m) _Pragma("unroll") for (int n = 0; n < 2; ++n) _Pragma("unroll") for (int k = 0; k < 2; ++k) \
        acc[ai][bj][m][n] = __builtin_amdgcn_mfma_f32_16x16x32_bf16(Bt[n][k], At[m][k], acc[ai][bj][m][n], 0, 0, 0); __builtin_amdgcn_s_setprio(0); } while (0)
#define PG8_WAIT_V(n) asm volatile("s_waitcnt vmcnt(" #n ")" ::: "memory")
#define PG8_WAIT_L(n) asm volatile("s_waitcnt lgkmcnt(" #n ")" ::: "memory")
#define PG8_BAR __builtin_amdgcn_s_barrier()
#define PG8_SCHED __builtin_amdgcn_sched_barrier(0)
    Unit cur, nxt; int ui = 0;
    if (!S.next(0, cur)) return;
    f32x4 acc[2][2][4][2];
#pragma unroll
    for (int a = 0; a < 2; ++a)
#pragma unroll
        for (int b = 0; b < 2; ++b)
#pragma unroll
            for (int m = 0; m < 4; ++m)
#pragma unroll
                for (int n = 0; n < 2; ++n) acc[a][b][m][n] = (f32x4){0.f, 0.f, 0.f, 0.f};
    bf16x8 At[4][2], B0[2][2], B1[2][2];
    const char* cA = cur.a; const char* cB = cur.b;
    PG8_STAGE(PG8_SB(0, 0), cB, voffB); PG8_STAGE(PG8_SB(0, 1), cB + hstep, voffB); PG8_STAGE(PG8_SA(0, 0), cA, voffA); PG8_STAGE(PG8_SA(0, 1), cA + hstep, voffA);
    if (wr == 1) PG8_BAR;
    PG8_WAIT_V(2); PG8_BAR;
    PG8_STAGE(PG8_SB(1, 0), cB + kstep, voffB); PG8_STAGE(PG8_SA(1, 0), cA + kstep, voffA); PG8_STAGE(PG8_SB(1, 1), cB + hstep + kstep, voffB);
    PG8_WAIT_V(6); PG8_BAR;
    for (;;) {
        const bool has_next = S.next(ui + 1, nxt);
        const char* nA = has_next ? nxt.a : cA; const char* nB = has_next ? nxt.b : cB;
        for (int t = 0; t < nt; t += 2) {
            const bool last = (t == nt - 2);
            const char* a1 = cA + (size_t)(t + 1) * kstep;
            const char* a2 = last ? nA : cA + (size_t)(t + 2) * kstep; const char* b2 = last ? nB : cB + (size_t)(t + 2) * kstep;
            const char* a3 = a2 + kstep; const char* b3 = b2 + kstep;
            PG8_LDB(B0, 0, 0); PG8_LDB(B1, 0, 1); PG8_SCHED; PG8_LDA(At, 0, 0); PG8_STAGE(PG8_SA(1, 1), a1 + hstep, voffA);
            PG8_WAIT_V(8); PG8_WAIT_L(0); PG8_BAR; PG8_MMA(0, 0, At, B0); PG8_MMA(0, 1, At, B1); PG8_BAR; PG8_SCHED;
            PG8_LDA(At, 0, 1); PG8_STAGE(PG8_SB(0, 0), b2, voffB); PG8_STAGE(PG8_SB(0, 1), b2 + hstep, voffB); PG8_STAGE(PG8_SA(0, 0), a2, voffA);
            PG8_WAIT_V(8); PG8_WAIT_L(0); PG8_BAR; PG8_MMA(1, 0, At, B0); PG8_MMA(1, 1, At, B1); PG8_BAR; PG8_SCHED;
            PG8_LDB(B0, 1, 0); PG8_LDB(B1, 1, 1); PG8_SCHED; PG8_LDA(At, 1, 0); PG8_STAGE(PG8_SA(0, 1), a2 + hstep, voffA);
            PG8_WAIT_V(8); PG8_WAIT_L(0); PG8_BAR; PG8_MMA(0, 0, At, B0); PG8_MMA(0, 1, At, B1); PG8_BAR; PG8_SCHED;
            PG8_LDA(At, 1, 1); PG8_STAGE(PG8_SB(1, 0), b3, voffB); PG8_STAGE(PG8_SB(1, 1), b3 + hstep, voffB); PG8_STAGE(PG8_SA(1, 0), a3, voffA);
            PG8_WAIT_V(8); PG8_WAIT_L(0); PG8_BAR; PG8_MMA(1, 0, At, B0); PG8_MMA(1, 1, At, B1); PG8_BAR; PG8_SCHED;
        }
        if (wr == 0) PG8_BAR;
        E(acc, cur);
        if (!has_next) break;
#pragma unroll
        for (int a = 0; a < 2; ++a)
#pragma unroll
            for (int b = 0; b < 2; ++b)
#pragma unroll
                for (int m = 0; m < 4; ++m)
#pragma unroll
                    for (int n = 0; n < 2; ++n) acc[a][b][m][n] = (f32x4){0.f, 0.f, 0.f, 0.f};
        cur = nxt; cA = nA; cB = nB; ++ui;
        if (wr == 1) PG8_BAR;
    }
    PG8_WAIT_V(0);
    PG8_BAR;
#undef PG8_SA
#undef PG8_SB
#undef PG8_STAGE
#undef PG8_LDA
#undef PG8_LDB
#undef PG8_MMA
#undef PG8_WAIT_V
#undef PG8_WAIT_L
#undef PG8_BAR
#undef PG8_SCHED
}
}

__device__ void transpose_cvt(LAS unsigned char* lds, const float* __restrict__ src, bf16_t* __restrict__ dst, int R, int C, const float* __restrict__ scale, int G, int bid) {
    LAS float* T = (LAS float*)lds;
    const int tid = opaque_tid(), lane = tid & 63, wid = tid >> 6;
    const int tc = C / 256, nt = (R / 64) * tc;
    for (int t = bid; t < nt; t += G) {
        const int r0 = (t / tc) * 64, c0 = (t % tc) * 256;
        __syncthreads();
#pragma unroll
        for (int i = 0; i < 8; ++i) { const int row = wid + 8 * i; const float sc = scale ? scale[r0 + row] : 1.f;
            const float* sp = src + (size_t)(r0 + row) * C + c0 + lane;
#pragma unroll
            for (int j = 0; j < 4; ++j) T[row * 257 + j * 64 + lane] = sp[j * 64] * sc; }
        __syncthreads();
        const int rp = lane & 31, cs = lane >> 5;
#pragma unroll
        for (int i = 0; i < 16; ++i) { const int cc = wid * 32 + i * 2 + cs;
            const unsigned w = cvt_pk_bf16(T[(2 * rp) * 257 + cc], T[(2 * rp + 1) * 257 + cc]);
            *(unsigned*)(dst + (size_t)(c0 + cc) * R + r0 + 2 * rp) = w; }
    }
}

__device__ void filter_gen(LAS unsigned char* lds, const Args& a, int G, int bid) {
    LAS float* F = (LAS float*)lds;
    LAS float* HA = F + 64 * 33;
    LAS float* HB = HA + 64 * 64;
    const int tid = opaque_tid(), lane = tid & 63, wid = __builtin_amdgcn_readfirstlane(tid >> 6);
    bf16_t* KR = (bf16_t*)(a.ws + WS_KR);
    const float MIN_DECAY = -15.350567286626973f, MAX_DECAY = -3.0701134573253945f;
    for (int it = bid; it < 256; it += G) {
        const int l = it >> 7, tt = (it >> 2) & 31, nc = it & 3;
        const int tlo = tt * 64 + ((nc & 1) ? 0 : 1);
        const float* w1 = a.fw1 + l * 33 * 64; const float* b1 = a.fb1 + l * 64; const float* w2 = a.fw2 + l * 64 * 64; const float* b2 = a.fb2 + l * 64;
        const float* w3 = a.fw3 + l * 64 * 64; const float* b3 = a.fb3 + l * 64; const float* w4 = a.fw4 + (size_t)l * 64 * 4096; const float* fr_ = a.ffreq + l * 64;
        __syncthreads();
        for (int idx = tid; idx < 64 * 33; idx += 512) {
            const int t = idx / 33, j = idx % 33; const int tg = tlo + t; float v;
            if (j == 0) v = (float)tg / (float)(SEQ - 1);
            else { const int bi = (j - 1) & 15; const float band = 1e-4f + (float)bi * ((15.f - 1e-4f) / 15.f);
                const float ang = ((float)(2.0 * 3.14159265358979323846 / SEQ) * (float)tg) * band; v = (j <= 16) ? cos_rr(ang) : -sin_rr(ang); }
            F[idx] = v;
        }
        __syncthreads();
        const int t = tid >> 3, j0 = (tid & 7) * 8;
        {   float s[8];
#pragma unroll
            for (int e = 0; e < 8; ++e) s[e] = b1[j0 + e];
#pragma unroll 11
            for (int k = 0; k < 33; ++k) { const float f = F[t * 33 + k];
#pragma unroll
                for (int e = 0; e < 8; ++e) s[e] += f * w1[k * 64 + j0 + e]; }
#pragma unroll
            for (int e = 0; e < 8; ++e) HA[t * 64 + j0 + e] = sin_rr(fr_[j0 + e] * s[e]);
        }
        __syncthreads();
        {   float s[8];
#pragma unroll
            for (int e = 0; e < 8; ++e) s[e] = b2[j0 + e];
#pragma unroll 16
            for (int k = 0; k < 64; ++k) { const float f = HA[t * 64 + k];
#pragma unroll
                for (int e = 0; e < 8; ++e) s[e] += f * w2[k * 64 + j0 + e]; }
#pragma unroll
            for (int e = 0; e < 8; ++e) HB[t * 64 + j0 + e] = sin_rr(fr_[j0 + e] * s[e]);
        }
        __syncthreads();
        {   float s[8];
#pragma unroll
            for (int e = 0; e < 8; ++e) s[e] = b3[j0 + e];
#pragma unroll 16
            for (int k = 0; k < 64; ++k) { const float f = HB[t * 64 + k];
#pragma unroll
                for (int e = 0; e < 8; ++e) s[e] += f * w3[k * 64 + j0 + e]; }
#pragma unroll
            for (int e = 0; e < 8; ++e) HA[t * 64 + j0 + e] = sin_rr(fr_[j0 + e] * s[e]);
        }
        __syncthreads();
        LAS bf16_t* TT = (LAS bf16_t*)(lds + 49152) + wid * (64 * 66);
#pragma unroll 1
        for (int chunk = 0; chunk < 2; ++chunk) {
            const int n0 = nc * 1024 + wid * 128 + chunk * 64, n = n0 + lane;
            float w[64];
#pragma unroll
            for (int k = 0; k < 64; ++k) w[k] = w4[(size_t)k * 4096 + n];
            const int o = n0 >> 11, dir = (n0 >> 10) & 1, c = n & 1023;
            const float delta = fabsf(MIN_DECAY + (float)c * ((MAX_DECAY - MIN_DECAY) / 1023.f));
#pragma unroll 4
            for (int t2 = 0; t2 < 64; ++t2) {
                float s0 = 0.f;
#pragma unroll
                for (int k4 = 0; k4 < 16; ++k4) { const f32x4 hv = *(const LAS f32x4*)(HA + t2 * 64 + k4 * 4);
                    s0 += hv[0] * w[4 * k4] + hv[1] * w[4 * k4 + 1] + hv[2] * w[4 * k4 + 2] + hv[3] * w[4 * k4 + 3]; }
                const int tg = tlo + t2; const float tn = (float)tg / (float)(SEQ - 1);
                s0 *= expf(-tn * delta);
                if (tg == SEQ) s0 = 0.f;
                TT[lane * 66 + (dir ? t2 : 63 - t2)] = f2bf(s0);
            }
            if (dir == 1 && tt == 0) {
                float sf = 0.f;
#pragma unroll 16
                for (int k = 0; k < 64; ++k) sf += HA[k] * w4[(size_t)k * 4096 + n - 1024];
                TT[lane * 66] = f2bf(sf);
            }
            const int idx0 = dir ? (2048 + tt * 64) : (1984 - tt * 64);
            bf16_t* rowb = KR + ((size_t)((l * 2 + o) * 1024 + (n0 & 1023))) * 4096;
            for (int r = 0; r < 64; ++r) rowb[(size_t)r * 4096 + idx0 + lane] = TT[r * 66 + lane];
        }
    }
}

__device__ void prologue(LAS unsigned char* lds, const Args& a, int G, int bid) {
    unsigned char* ws = a.ws;
    for (int l = 0; l < 2; ++l) {
        transpose_cvt(lds, a.w_in + (size_t)l * DM * NIN, (bf16_t*)(ws + WS_WIN) + (size_t)l * NIN * DM, DM, NIN, a.norm_g + l * DM, G, bid);
        transpose_cvt(lds, a.w_hy + (size_t)l * HW * DM, (bf16_t*)(ws + WS_WH) + (size_t)l * DM * HW, HW, DM, nullptr, G, bid);
        transpose_cvt(lds, a.w_at + (size_t)l * HW * DM, (bf16_t*)(ws + WS_WA) + (size_t)l * DM * HW, HW, DM, nullptr, G, bid);
        transpose_cvt(lds, a.w_out + (size_t)l * DM * DM, (bf16_t*)(ws + WS_WO) + (size_t)l * DM * DM, DM, DM, nullptr, G, bid);
    }
    filter_gen(lds, a, G, bid);
    {
        float* rope = (float*)(ws + WS_ROPE);
        for (int idx = bid * 512 + opaque_tid(); idx < SEQ * 16; idx += G * 512) {
            const int pos = idx >> 4, i = idx & 15;
            const float inv = exp2f(-(float)(2 * i) * (18.931568569324174f / 32.0f)), ang = (float)pos * inv;
            rope[pos * 32 + i] = cos_rr(ang); rope[pos * 32 + 16 + i] = sin_rr(ang);
        }
    }
    {
        float* ssq = (float*)(ws + WS_SSQ); bf16_t* XB = (bf16_t*)(ws + WS_XB);
        const int tid = opaque_tid(), lane = tid & 63, wid = tid >> 6;
        for (int row = bid * 8 + wid; row < MTOK; row += G * 8) {
            const float* xr = a.x + (size_t)row * DM; float ss = 0.f;
#pragma unroll
            for (int i = 0; i < 4; ++i) {
                const f32x4 v0 = *(const f32x4*)(xr + i * 512 + lane * 8), v1 = *(const f32x4*)(xr + i * 512 + lane * 8 + 4);
                ss += (v0[0] * v0[0] + v0[1] * v0[1]) + (v0[2] * v0[2] + v0[3] * v0[3]) + (v1[0] * v1[0] + v1[1] * v1[1]) + (v1[2] * v1[2] + v1[3] * v1[3]);
                u32x4 w; w.x = cvt_pk_bf16(v0[0], v0[1]); w.y = cvt_pk_bf16(v0[2], v0[3]); w.z = cvt_pk_bf16(v1[0], v1[1]); w.w = cvt_pk_bf16(v1[2], v1[3]);
                *(u32x4*)(XB + (size_t)row * DM + i * 512 + lane * 8) = w;
            }
#pragma unroll
            for (int o = 32; o >= 1; o >>= 1) ss += __shfl_xor(ss, o);
            if (lane == 0) { ssq[row] = ss; ssq[MTOK + row] = 0.f; ssq[2 * MTOK + row] = 0.f; }
        }
    }
}

__device__ void ssq_reduce(const Args& a, int bid) {
    const float* ssqp = (const float*)(a.ws + WS_SSQP); float* ssq = (float*)(a.ws + WS_SSQ) + MTOK;
    const int tid = opaque_tid();
    for (int row = bid * 64 + tid; row < MTOK && tid < 64; row += gridDim.x * 64) {
        float s0 = 0.f;
#pragma unroll
        for (int j = 0; j < 8; ++j) { const f32x4 p0 = *(const f32x4*)(ssqp + (size_t)row * 32 + j * 4); s0 += (p0[0] + p0[1]) + (p0[2] + p0[3]); }
        ssq[row] = s0;
    }
}

__device__ void final_norm(const Args& a, int G, int bid, float* dstp) {
    const float* ssqp = (const float*)(a.ws + WS_SSQP);
    const int tid = opaque_tid(), lane = tid & 63, wid = tid >> 6;
    for (int row = (bid * 8 + wid) * 2; row < MTOK; row += G * 16) {
        float s0 = 0.f, s1 = 0.f;
#pragma unroll
        for (int j = 0; j < 8; ++j) { const f32x4 p0 = *(const f32x4*)(ssqp + (size_t)row * 32 + j * 4), p1 = *(const f32x4*)(ssqp + (size_t)(row + 1) * 32 + j * 4);
            s0 += (p0[0] + p0[1]) + (p0[2] + p0[3]); s1 += (p1[0] + p1[1]) + (p1[2] + p1[3]); }
        const float rs0 = __builtin_amdgcn_rsqf(s0 * (1.f / DM) + EPS), rs1 = __builtin_amdgcn_rsqf(s1 * (1.f / DM) + EPS);
        const float* xr = a.out + (size_t)row * DM; float* xw = dstp + (size_t)row * DM;
        f32x4 v[16];
#pragma unroll
        for (int i = 0; i < 16; ++i) v[i] = *(const f32x4*)(xr + i * 256 + lane * 4);
#pragma unroll
        for (int i = 0; i < 16; ++i) { const f32x4 g = *(const f32x4*)(a.fnorm + (i & 7) * 256 + lane * 4);
            *(f32x4*)(xw + i * 256 + lane * 4) = v[i] * (i < 8 ? rs0 : rs1) * g; }
    }
}

constexpr int HY_PITCH = 4112, HY_UB = 0, HY_KR0 = 33024, HY_KRSZ = 8448, HY_YB = 50176;
__device__ __forceinline__ bf16x8 hy_ldA(const LAS unsigned char* kr, int byteoff) {
    const LAS unsigned* p = (const LAS unsigned*)(kr + byteoff);
    u32x4 v; v.x = p[0]; v.y = p[1]; v.z = p[2]; v.w = p[3];
    return __builtin_bit_cast(bf16x8, v);
}
__device__ __forceinline__ bf16x8 hy_ldB(const LAS unsigned char* p, unsigned sh) {
    const u32x4 w = *(const LAS u32x4*)p; const unsigned w4 = *(const LAS unsigned*)(p + 16);
    u32x4 o; o.x = __builtin_amdgcn_alignbit(w.y, w.x, sh); o.y = __builtin_amdgcn_alignbit(w.z, w.y, sh); o.z = __builtin_amdgcn_alignbit(w.w, w.z, sh); o.w = __builtin_amdgcn_alignbit(w4, w.w, sh);
    return __builtin_bit_cast(bf16x8, o);
}
__device__ __forceinline__ void hy_conv(f32x4 (&acc)[8], const LAS unsigned char* kr, const LAS unsigned char* ubrow, int abase, int mi0, unsigned sh) {
#pragma unroll
    for (int q = 0; q < 8; ++q) acc[q] = (f32x4){0.f, 0.f, 0.f, 0.f};
    bf16x8 A[8];
#pragma unroll
    for (int q = 0; q < 8; ++q) A[q] = hy_ldA(kr, abase - 64 * (mi0 + q));
    bf16x8 B = hy_ldB(ubrow, sh);
    for (int k = 0; k < 8; ++k) {
#pragma unroll
        for (int u = 0; u < 8; ++u) {
            const int si = 8 * k + u;
            const bf16x8 Bn = hy_ldB(ubrow + ((si + 1) & 63) * 64, sh);
            const bf16x8 An = hy_ldA(kr, abase - 64 * (mi0 - si - 1));
            __builtin_amdgcn_s_setprio(1);
#pragma unroll
            for (int q = 0; q < 8; ++q) acc[q] = __builtin_amdgcn_mfma_f32_16x16x32_bf16(A[(q - u) & 7], B, acc[q], 0, 0, 0);
            __builtin_amdgcn_s_setprio(0);
            A[(7 - u) & 7] = An; B = Bn;
        }
    }
}
__device__ __forceinline__ f32x4 hy_sc4(const u32x4 ch, float prev, float next, int r, float w0, float w1, float w2, float bs) {
    const float x0 = bflo(ch.x), x1 = bfhi(ch.x), x2 = bflo(ch.y), x3 = bfhi(ch.y), x4 = bflo(ch.z), x5 = bfhi(ch.z), x6 = bflo(ch.w), x7 = bfhi(ch.w);
    f32x4 o;
    o[0] = bs + w0 * (r ? x0 : prev) + w1 * (r ? x1 : x0) + w2 * (r ? x2 : x1);
    o[1] = bs + w0 * (r ? x2 : x1) + w1 * (r ? x3 : x2) + w2 * (r ? x4 : x3);
    o[2] = bs + w0 * (r ? x4 : x3) + w1 * (r ? x5 : x4) + w2 * (r ? x6 : x5);
    o[3] = bs + w0 * (r ? x6 : x5) + w1 * (r ? x7 : x6) + w2 * (r ? next : x7);
    return o;
}
__device__ __forceinline__ f32x4 hy_load_sc4(const bf16_t* rowp, int t0, int r, float w0, float w1, float w2, float bs) {
    const u32x4 ch = *(const u32x4*)(rowp + t0);
    const unsigned pv = rowp[t0 > 0 ? t0 - 1 : 0], nv = rowp[t0 + 8 < SEQ ? t0 + 8 : SEQ - 1];
    const float prev = t0 > 0 ? bf2f(pv) : 0.f, next = (t0 + 8 < SEQ) ? bf2f(nv) : 0.f;
    return hy_sc4(ch, prev, next, r, w0, w1, w2, bs);
}

__device__ void hyena_item(LAS unsigned char* lds, const Args& a, int l, int c4) {
    const bf16_t* UT = (const bf16_t*)(a.ws + WS_UT);
    const bf16_t* KRg = (const bf16_t*)(a.ws + WS_KR);
    bf16_t* YH = (bf16_t*)(a.ws + WS_YH);
    LAS unsigned char* ub = lds + HY_UB;
    const float* cw = a.conv_w + (size_t)l * 3 * 3072; const float* cb = a.conv_b + (size_t)l * 3072;
#pragma unroll 1
    for (int ch = 0; ch < 4; ++ch) {
    const int c = c4 * 4 + ch;
    const int tid = opaque_tid(), lane = tid & 63, wid = __builtin_amdgcn_readfirstlane(tid >> 6), fr = lane & 15, fq = lane >> 4;
    __syncthreads();
#pragma unroll
    for (int o = 0; o < 2; ++o)
        *(LAS u32x4*)(lds + HY_KR0 + o * HY_KRSZ + tid * 16) = *(const u32x4*)(KRg + ((size_t)((l * 2 + o) * 1024 + c)) * 4096 + tid * 8);
    {   const float w0 = cw[c], w1 = cw[3072 + c], w2 = cw[2 * 3072 + c], bs = cb[c];
        const bf16_t* rowp = UT + (size_t)c * MTOK;
#pragma unroll
        for (int i = 0; i < 4; ++i) {
            const int q = tid + 512 * i, b = q >> 8, t0 = (q & 255) * 8;
            const bf16_t* rp = rowp + b * SEQ;
            const f32x4 e0 = hy_load_sc4(rp, t0, 0, w0, w1, w2, bs), e1 = hy_load_sc4(rp, t0, 1, w0, w1, w2, bs);
            u32x4 w; w.x = cvt_pk_bf16(e0[0], e1[0]); w.y = cvt_pk_bf16(e0[1], e1[1]); w.z = cvt_pk_bf16(e0[2], e1[2]); w.w = cvt_pk_bf16(e0[3], e1[3]);
            *(LAS u32x4*)(ub + b * HY_PITCH + t0 * 2) = w;
            if (t0 == SEQ - 8) *(LAS u32x4*)(ub + b * HY_PITCH + SEQ * 2) = (u32x4){0u, 0u, 0u, 0u};
        }
    }
    __syncthreads();
    const int b = fr >> 1, r = fr & 1, mi0 = wid * 8;
    const unsigned sh = 16u * (unsigned)r;
    const int abase = 4096 - 4 * fr + 16 * fq;
    const LAS unsigned char* ubrow = ub + b * HY_PITCH + fq * 16;
    f32x4 acc[8];
    u32x4 pc[8]; unsigned pp[8], pn[8];
    {   const bf16_t* rp = UT + (size_t)(1024 + c) * MTOK + b * SEQ;
#pragma unroll
        for (int q = 0; q < 8; ++q) { const int t0 = 32 * (mi0 + q) + 8 * fq;
            pc[q] = *(const u32x4*)(rp + t0); pp[q] = rp[t0 > 0 ? t0 - 1 : 0]; pn[q] = rp[t0 + 8 < SEQ ? t0 + 8 : SEQ - 1]; }
    }
    hy_conv(acc, lds + HY_KR0, ubrow, abase, mi0, sh);
    const float u0 = bf2f(*(const LAS bf16_t*)(ub + b * HY_PITCH));
    __syncthreads();
    {   const float bias0 = a.hbias[(size_t)(l * 2 + 0) * 1024 + c];
        const float w0 = cw[1024 + c], w1 = cw[3072 + 1024 + c], w2 = cw[2 * 3072 + 1024 + c], bs = cb[1024 + c];
#pragma unroll
        for (int q = 0; q < 8; ++q) {
            const int t0 = 32 * (mi0 + q) + 8 * fq;
            const f32x4 hx1 = hy_sc4(pc[q], t0 > 0 ? bf2f(pp[q]) : 0.f, (t0 + 8 < SEQ) ? bf2f(pn[q]) : 0.f, r, w0, w1, w2, bs);
#pragma unroll
            for (int j = 0; j < 4; ++j) {
                const int t = t0 + 2 * j + r;
                const float hv = bf2f(*(const LAS bf16_t*)(ub + b * HY_PITCH + t * 2));
                float v = acc[q][j] + bias0 * hv;
                if (r) v += bf2f(*(const LAS bf16_t*)(lds + HY_KR0 + (2048 - t) * 2)) * u0;
                acc[q][j] = hx1[j] * v;
            }
        }
    }
    __syncthreads();
#pragma unroll
    for (int q = 0; q < 8; ++q)
#pragma unroll
        for (int j = 0; j < 4; ++j) { const int t = 32 * (mi0 + q) + 8 * fq + 2 * j + r; *(LAS bf16_t*)(ub + b * HY_PITCH + t * 2) = f2bf(acc[q][j]); }
    u32x2 zq[8];
    {   const bf16_t* rp = UT + (size_t)(2048 + c) * MTOK + b * SEQ;
        const bf16_t* zp = UT + (size_t)(3072 + c) * MTOK + b * SEQ;
#pragma unroll
        for (int q = 0; q < 8; ++q) { const int t0 = 32 * (mi0 + q) + 8 * fq;
            pc[q] = *(const u32x4*)(rp + t0); pp[q] = rp[t0 > 0 ? t0 - 1 : 0]; pn[q] = rp[t0 + 8 < SEQ ? t0 + 8 : SEQ - 1];
            const u32x4 zc = *(const u32x4*)(zp + t0);
            zq[q].x = r ? ((zc.x >> 16) | (zc.y & 0xffff0000u)) : ((zc.x & 0xffffu) | (zc.y << 16));
            zq[q].y = r ? ((zc.z >> 16) | (zc.w & 0xffff0000u)) : ((zc.z & 0xffffu) | (zc.w << 16)); }
    }
    __syncthreads();
    if (PROBE_DUP == 10) { hy_conv(acc, lds + HY_KR0 + HY_KRSZ, ubrow, abase, mi0, sh); asm volatile("" :: "v"(acc[0]), "v"(acc[1]), "v"(acc[2]), "v"(acc[3]), "v"(acc[4]), "v"(acc[5]), "v"(acc[6]), "v"(acc[7])); }
    hy_conv(acc, lds + HY_KR0 + HY_KRSZ, ubrow, abase, mi0, sh);
    {   const float z0 = bf2f(*(const LAS bf16_t*)(ub + b * HY_PITCH));
        const float bias1 = a.hbias[(size_t)(l * 2 + 1) * 1024 + c];
        const float w0 = cw[2048 + c], w1 = cw[3072 + 2048 + c], w2 = cw[2 * 3072 + 2048 + c], bs = cb[2048 + c];
#pragma unroll
        for (int q = 0; q < 8; ++q) {
            const int t0 = 32 * (mi0 + q) + 8 * fq;
            const f32x4 hx2 = hy_sc4(pc[q], t0 > 0 ? bf2f(pp[q]) : 0.f, (t0 + 8 < SEQ) ? bf2f(pn[q]) : 0.f, r, w0, w1, w2, bs);
            const float zh[4] = {bflo(zq[q].x), bfhi(zq[q].x), bflo(zq[q].y), bfhi(zq[q].y)};
#pragma unroll
            for (int j = 0; j < 4; ++j) {
                const int t = t0 + 2 * j + r;
                const float z = bf2f(*(const LAS bf16_t*)(ub + b * HY_PITCH + t * 2));
                float v = acc[q][j] + bias1 * z;
                if (r) v += bf2f(*(const LAS bf16_t*)(lds + HY_KR0 + HY_KRSZ + (2048 - t) * 2)) * z0;
                acc[q][j] = hx2[j] * v * zh[j];
            }
        }
    }
    {   unsigned pk[16];
#pragma unroll
        for (int q = 0; q < 8; ++q) { pk[2 * q] = cvt_pk_bf16(acc[q][0], acc[q][1]); pk[2 * q + 1] = cvt_pk_bf16(acc[q][2], acc[q][3]); }
        LAS unsigned char* yb = lds + HY_YB + tid * 16;
        if (ch < 3) {
#pragma unroll
            for (int k = 0; k < 4; ++k) *(LAS u32x4*)(yb + ch * 32768 + k * 8192) = (u32x4){pk[4 * k], pk[4 * k + 1], pk[4 * k + 2], pk[4 * k + 3]};
        } else {
#pragma unroll
            for (int k = 0; k < 4; ++k) {
                const u32x4 p0 = *(const LAS u32x4*)(yb + k * 8192), p1 = *(const LAS u32x4*)(yb + 32768 + k * 8192), p2 = *(const LAS u32x4*)(yb + 65536 + k * 8192);
#pragma unroll
                for (int e = 0; e < 4; ++e) {
                    const int q = 2 * k + (e >> 1), j0 = 2 * (e & 1);
                    const unsigned d0 = p0[e], d1 = p1[e], d2 = p2[e], d3 = pk[4 * k + e];
                    const int t = 32 * (mi0 + q) + 8 * fq + 2 * j0 + r;
                    bf16_t* yp = YH + (size_t)(b * SEQ + t) * HW + c4 * 4;
                    *(u32x2*)yp = (u32x2){(d0 & 0xffffu) | (d1 << 16), (d2 & 0xffffu) | (d3 << 16)};
                    *(u32x2*)(yp + 2 * HW) = (u32x2){(d0 >> 16) | (d1 & 0xffff0000u), (d2 >> 16) | (d3 & 0xffff0000u)};
                }
            }
            asm volatile("s_waitcnt vmcnt(0)" ::: "memory");
        }
    }
    }
}

constexpr int AT_PITCH = 272, AT_KS = 0, AT_VS = 128 * AT_PITCH;
__device__ void attn_item(LAS unsigned char* lds, const Args& a, int l, int item) {
    const int tid = opaque_tid(), lane = tid & 63, wid = __builtin_amdgcn_readfirstlane(tid >> 6), fr = lane & 15, fq = lane >> 4;
    const int hp = item & 3, qb = (item >> 2) & 15, b = item >> 6, kvh = hp >> 1, head = 2 * hp + (wid >> 2), qrow0 = 32 * (wid & 3);
    const bf16_t* Q = (const bf16_t*)(a.ws + WS_Q); const bf16_t* Kg = (const bf16_t*)(a.ws + WS_K); const bf16_t* VT = (const bf16_t*)(a.ws + WS_VT);
    const bf16_t* ZA = (const bf16_t*)(a.ws + WS_ZA); bf16_t* YA = (bf16_t*)(a.ws + WS_YA);
    constexpr float LOG2E = 1.4426950408889634f, SC2 = 0.08838834764831845f * LOG2E;
    bf16x8 qf[2][4];
#pragma unroll
    for (int qt = 0; qt < 2; ++qt)
#pragma unroll
        for (int ks = 0; ks < 4; ++ks)
            qf[qt][ks] = *(const bf16x8*)(Q + (size_t)(b * SEQ + qb * 128 + qrow0 + 16 * qt + fr) * 1024 + head * 128 + 32 * ks + 8 * fq);
    f32x4 O[2][8];
#pragma unroll
    for (int qt = 0; qt < 2; ++qt)
#pragma unroll
        for (int dt = 0; dt < 8; ++dt) O[qt][dt] = (f32x4){0.f, 0.f, 0.f, 0.f};
    const float sink2 = a.sink[l * 8 + head] * LOG2E;
    float mrun[2] = {sink2, sink2}, lsum[2] = {fq == 0 ? 1.f : 0.f, fq == 0 ? 1.f : 0.f};
    for (int rel = -1; rel <= 1; ++rel) {
        const int kt = qb + rel;
        if (kt < 0 || kt > 15) continue;
        __syncthreads();
#pragma unroll
        for (int i = 0; i < 4; ++i) {
            const int q = tid + 512 * i, row = q >> 4, ch = q & 15;
            *(LAS u32x4*)(lds + AT_KS + row * AT_PITCH + ch * 16) = *(const u32x4*)(Kg + (size_t)(b * SEQ + kt * 128 + row) * 256 + kvh * 128 + ch * 8);
            *(LAS u32x4*)(lds + AT_VS + row * AT_PITCH + ch * 16) = *(const u32x4*)(VT + (size_t)(kvh * 128 + row) * MTOK + b * SEQ + kt * 128 + ch * 8);
        }
        __syncthreads();
#pragma unroll
        for (int kh = 0; kh < 2; ++kh) {
            if ((rel < 0 && kh == 0 && qrow0 >= 64) || (rel > 0 && kh == 1 && qrow0 < 64)) continue;
            f32x4 S[2][4];
#pragma unroll
            for (int qt = 0; qt < 2; ++qt)
#pragma unroll
                for (int st = 0; st < 4; ++st) S[qt][st] = (f32x4){0.f, 0.f, 0.f, 0.f};
#pragma unroll
            for (int st = 0; st < 4; ++st)
#pragma unroll
                for (int ks = 0; ks < 4; ++ks) {
                    const bf16x8 kf = *(const LAS bf16x8*)(lds + AT_KS + (64 * kh + 16 * st + fr) * AT_PITCH + (32 * ks + 8 * fq) * 2);
#pragma unroll
                    for (int qt = 0; qt < 2; ++qt) S[qt][st] = __builtin_amdgcn_mfma_f32_16x16x32_bf16(kf, qf[qt][ks], S[qt][st], 0, 0, 0);
                }
            bf16x8 pf[2][2];
#pragma unroll
            for (int qt = 0; qt < 2; ++qt) {
                const int qq = qrow0 + 16 * qt + fr;
                float mx = -INFINITY;
#pragma unroll
                for (int st = 0; st < 4; ++st)
#pragma unroll
                    for (int j = 0; j < 4; ++j) {
                        const int kk = 64 * kh + 16 * st + 4 * fq + j;
                        const bool valid = (rel == 0) || (rel < 0 ? (kk >= qq) : (kk <= qq));
                        const float s = valid ? S[qt][st][j] * SC2 : -INFINITY;
                        S[qt][st][j] = s; mx = fmaxf(mx, s);
                    }
                mx = fmaxf(mx, __shfl_xor(mx, 16)); mx = fmaxf(mx, __shfl_xor(mx, 32));
                const float mnew = fmaxf(mrun[qt], mx), alpha = __builtin_amdgcn_exp2f(mrun[qt] - mnew);
                mrun[qt] = mnew;
                float ps = 0.f;
#pragma unroll
                for (int st = 0; st < 4; ++st)
#pragma unroll
                    for (int j = 0; j < 4; ++j) { const float p = __builtin_amdgcn_exp2f(S[qt][st][j] - mnew); S[qt][st][j] = p; ps += p; }
                lsum[qt] = lsum[qt] * alpha + ps;
#pragma unroll
                for (int dt = 0; dt < 8; ++dt) O[qt][dt] = O[qt][dt] * alpha;
#pragma unroll
                for (int kp = 0; kp < 2; ++kp) {
                    u32x4 w; w.x = cvt_pk_bf16(S[qt][2 * kp][0], S[qt][2 * kp][1]); w.y = cvt_pk_bf16(S[qt][2 * kp][2], S[qt][2 * kp][3]);
                    w.z = cvt_pk_bf16(S[qt][2 * kp + 1][0], S[qt][2 * kp + 1][1]); w.w = cvt_pk_bf16(S[qt][2 * kp + 1][2], S[qt][2 * kp + 1][3]);
                    pf[qt][kp] = __builtin_bit_cast(bf16x8, w);
                }
            }
#pragma unroll
            for (int kp = 0; kp < 2; ++kp)
#pragma unroll
                for (int dt = 0; dt < 8; ++dt) {
                    const LAS unsigned char* vp = lds + AT_VS + (16 * dt + fr) * AT_PITCH + (64 * kh + 32 * kp + 4 * fq) * 2;
                    const u32x2 v0 = *(const LAS u32x2*)vp, v1 = *(const LAS u32x2*)(vp + 32);
                    const u32x4 vv = {v0.x, v0.y, v1.x, v1.y};
                    const bf16x8 vf = __builtin_bit_cast(bf16x8, vv);
#pragma unroll
                    for (int qt = 0; qt < 2; ++qt) O[qt][dt] = __builtin_amdgcn_mfma_f32_16x16x32_bf16(vf, pf[qt][kp], O[qt][dt], 0, 0, 0);
                }
        }
    }
#pragma unroll
    for (int qt = 0; qt < 2; ++qt) {
        float ls = lsum[qt]; ls += __shfl_xor(ls, 16); ls += __shfl_xor(ls, 32);
        const float inv = 1.f / ls;
        const size_t rowoff = (size_t)(b * SEQ + qb * 128 + qrow0 + 16 * qt + fr) * 1024 + head * 128 + 4 * fq;
        u32x2 zv[8];
#pragma unroll
        for (int dt = 0; dt < 8; ++dt) zv[dt] = *(const u32x2*)(ZA + rowoff + 16 * dt);
        asm volatile("s_waitcnt vmcnt(0)" ::: "memory");
#pragma unroll
        for (int dt = 0; dt < 8; ++dt) {
            const u32x2 z = zv[dt];
            const f32x4 o = O[qt][dt] * inv;
            u32x2 w; w.x = cvt_pk_bf16(o[0] * bflo(z.x), o[1] * bfhi(z.x)); w.y = cvt_pk_bf16(o[2] * bflo(z.y), o[3] * bfhi(z.y));
            *(u32x2*)(YA + rowoff + 16 * dt) = w;
        }
        asm volatile("s_waitcnt vmcnt(0)" ::: "memory");
    }
}

__device__ void mix_phase(LAS unsigned char* lds, const Args& a, int l, int G, int bid) {
    const int vcu = (G % 8 == 0) ? (bid % 8) * (G / 8) + bid / 8 : bid;
    for (int it = vcu; it < 256 + 512; it += G) {
        if (it < 256) { hyena_item(lds, a, l, it); if (PROBE_DUP == 8) hyena_item(lds, a, l, it); }
        else { attn_item(lds, a, l, it - 256); if (PROBE_DUP == 9) attn_item(lds, a, l, it - 256); }
    }
    __syncthreads();
}


#define XB_TMO      128
#define XB_XCNT(j)  (256  + 64 * (j))
#define XB_XSUB(j)  (1280 + 64 * (j))
#define XB_XGEN(j)  (2304 + 64 * (j))
#define XB_TOP      3328
#define XB_TOPGEN   3392
#define XCD_BAR_WORDS 3456
#define XB_SPIN_CAP (1u << 21)
__device__ __forceinline__ unsigned xb_ld(unsigned* p)              { return __hip_atomic_load(p, __ATOMIC_RELAXED, __HIP_MEMORY_SCOPE_AGENT); }
__device__ __forceinline__ unsigned xb_add(unsigned* p, unsigned v) { return __hip_atomic_fetch_add(p, v, __ATOMIC_RELAXED, __HIP_MEMORY_SCOPE_AGENT); }
__device__ __forceinline__ unsigned xb_xcc_id() { return (unsigned)__builtin_amdgcn_s_getreg((3 << 11) | 20) & 0xFu; }
#define XB_SPIN(cond, bar) do { unsigned _sp = 0; while (cond) { __builtin_amdgcn_s_sleep(1); \
    if ((++_sp & 255u) == 0u) { if (xb_ld(&(bar)[XB_TMO])) break; if (_sp > XB_SPIN_CAP) { atomicAdd(&(bar)[XB_TMO], 1u); break; } } } } while (0)
struct XcdBarrier { unsigned* bar; unsigned x; volatile LAS unsigned* st; };
__device__ __forceinline__ XcdBarrier xcd_barrier_post(unsigned* bar, volatile LAS unsigned* st) {
    XcdBarrier b; b.bar = bar; b.x = xb_xcc_id(); b.st = st;
    if (threadIdx.x == 0) (void)xb_add(&bar[XB_XCNT(b.x)], 1u);
    return b;
}
__device__ __forceinline__ void xcd_barrier_complete(unsigned* bar, unsigned x, unsigned& nloc, unsigned& nx) {
    const unsigned G = gridDim.x * gridDim.y * gridDim.z;
    unsigned sum, cnt, mine, sp = 0u;
    for (;;) {
        sum = 0u; cnt = 0u; mine = 0u;
#pragma unroll
        for (unsigned j = 0; j < 16; ++j) { const unsigned c = xb_ld(&bar[XB_XCNT(j)]); sum += c; cnt += (c > 0u) ? 1u : 0u; mine = (j == x) ? c : mine; }
        if (sum == G) break;
        __builtin_amdgcn_s_sleep(1);
        if ((++sp & 255u) == 0u) { if (xb_ld(&bar[XB_TMO])) break; if (sp > XB_SPIN_CAP) { atomicAdd(&bar[XB_TMO], 1u); break; } }
    }
    nloc = mine > 0u ? mine : 1u; nx = cnt > 0u ? cnt : 1u;
}
__device__ __forceinline__ void xcd_barrier(const XcdBarrier& b) {
    asm volatile("s_waitcnt vmcnt(0)" ::: "memory");
    __syncthreads();
    if (threadIdx.x == 0) {
        unsigned* bar = b.bar;
        __builtin_amdgcn_s_waitcnt(0);
        unsigned nloc = b.st[0], nx = b.st[1];
        if (nloc == 0u) { xcd_barrier_complete(bar, b.x, nloc, nx); b.st[0] = nloc; b.st[1] = nx; }
        const unsigned old = xb_add(&bar[XB_XSUB(b.x)], 1u);
        const unsigned gen = old / nloc;
        if (old + 1u == (gen + 1u) * nloc) {
            __builtin_amdgcn_fence(__ATOMIC_RELEASE, "agent");
            asm volatile("s_waitcnt vmcnt(0)" ::: "memory");
            const unsigned og = xb_add(&bar[XB_TOP], 1u);
            const unsigned tg = og / nx;
            if (og + 1u == (tg + 1u) * nx) xb_add(&bar[XB_TOPGEN], 1u);
            else XB_SPIN(xb_ld(&bar[XB_TOPGEN]) == tg, bar);
            __builtin_amdgcn_fence(__ATOMIC_ACQUIRE, "agent");
            xb_add(&bar[XB_XGEN(b.x)], 1u);
            asm volatile("s_waitcnt vmcnt(0)" ::: "memory");
        } else {
            XB_SPIN(xb_ld(&bar[XB_XGEN(b.x)]) == gen, bar);
            __builtin_amdgcn_fence(__ATOMIC_ACQUIRE, "agent");
            asm volatile("s_waitcnt vmcnt(0)" ::: "memory");
        }
    }
    __syncthreads();
}

__global__ void __launch_bounds__(512, 2) hybrid_fwd(Args a) {
    extern __shared__ __attribute__((aligned(16))) unsigned char lds_raw[];
    LAS unsigned char* lds = (LAS unsigned char*)lds_raw;
    const int G = gridDim.x, bid = blockIdx.x;
    unsigned char* ws = a.ws;
    {   volatile LAS unsigned* st0 = (volatile LAS unsigned*)(lds + LDS_ST); if (threadIdx.x < 2) st0[threadIdx.x] = 0u; }
    __syncthreads();
    XcdBarrier xbar = xcd_barrier_post((unsigned*)(ws + WS_BAR), (volatile LAS unsigned*)(lds + LDS_ST));
    if (a.ph_lo < 0) cg::this_grid().sync();
    bool redo = false;
    for (int ph = a.ph_lo; ph < a.ph_hi; ++ph) {
        bool sync_after = true;
        const int l = (ph < 6) ? 0 : 1, k = (ph < 6) ? ph - 1 : ph - 7;
        const int kind = (ph == 0) ? 1 : (ph == NPHASE - 1) ? 6 : (ph == 6) ? 11 : (k == 0) ? 2 : (k == 1) ? 3 : (k == 4) ? 5 : 4;
        const int nrep = (PROBE_DUP != 0 && PROBE_DUP != 4 && PROBE_DUP == kind) ? 2 : 1;
        for (int rep = 0; rep < nrep; ++rep) {
        if (ph == 0) prologue(lds, a, G, bid);
        else if (ph == 6) ssq_reduce(a, bid);
        else if (ph == NPHASE - 1) { final_norm(a, G, bid, (PROBE_DUP == 6 && rep == 0) ? (float*)(ws + WS_UT) : a.out); sync_after = false; }
        else {
            if (k == 1) mix_phase(lds, a, l, G, bid);
            else {
                pg8::Sched S; pg8::Epi E;
                E.l = l; E.ws = ws; E.xold = (l == 0) ? a.x : a.out; E.noss = (rep + 1 < nrep); E.xnew = (PROBE_DUP == 5 && E.noss) ? (float*)(ws + WS_GH) : a.out;
                if (k == 0) { E.mode = 0; S.init(0, NIN, DM, ws + WS_XB, (bf16_t*)(ws + WS_WIN) + (size_t)l * NIN * DM); }
                else if (k == 2) { E.mode = 1; S.init(1, DM, HW, ws + WS_YH, (bf16_t*)(ws + WS_WH) + (size_t)l * DM * HW); sync_after = false; }
                else if (k == 3) { E.mode = 2; S.init(1, DM, HW, ws + WS_YA, (bf16_t*)(ws + WS_WA) + (size_t)l * DM * HW); }
                else { E.mode = 3; S.init(1, DM, DM, ws + WS_MG, (bf16_t*)(ws + WS_WO) + (size_t)l * DM * DM); }
                pg8::gemm_phase(lds, S, E);
            }
        }
        }
        if (PROBE_DUP == 4 && kind == 4 && k == 3) { if (!redo) { redo = true; ph -= 2; continue; } redo = false; }
        if (sync_after && ph + 1 < a.ph_hi) { xcd_barrier(xbar); if (PROBE_DUP == 7) xcd_barrier(xbar); }
    }
}

extern "C" void kernel_launch(void* const* d_in, const int* in_sizes, int n_in, void* d_out, int out_size, void* d_ws, size_t ws_size, hipStream_t stream) {
    static int grid = 0;
    if (grid == 0) {
        if (n_in != 19 || out_size != MTOK * DM || ws_size < WS_END) { fprintf(stderr, "kernel_launch: unexpected shapes (n_in %d out %d ws %zu)\n", n_in, out_size, ws_size); grid = -1; return; }
        int dev = 0, cus = 0, per_cu = 0;
        hipGetDevice(&dev); hipDeviceGetAttribute(&cus, hipDeviceAttributeMultiprocessorCount, dev);
        if (hipFuncSetAttribute((const void*)hybrid_fwd, hipFuncAttributeMaxDynamicSharedMemorySize, LDS_BYTES) != hipSuccess) { fprintf(stderr, "kernel_launch: hipFuncSetAttribute failed\n"); grid = -1; return; }
        if (hipOccupancyMaxActiveBlocksPerMultiprocessor(&per_cu, (const void*)hybrid_fwd, 512, LDS_BYTES) != hipSuccess || per_cu < 1) { fprintf(stderr, "kernel_launch: occupancy query gave %d\n", per_cu); per_cu = 1; }
        (void)hipGetLastError();
        grid = cus * 1;
        if (grid <= 0) grid = 256;
    }
    if (grid < 0) return;
    if (hipMemsetAsync((char*)d_ws + WS_BAR, 0, 16384, stream) != hipSuccess) { fprintf(stderr, "kernel_launch: memset of barrier words failed\n"); return; }
    Args a{};
    const float** slots = (const float**)&a;
    for (int i = 0; i < 19; ++i) slots[i] = (const float*)d_in[i];
    a.out = (float*)d_out; a.ws = (unsigned char*)d_ws;
#if MK_MULTI
    for (int ph = 0; ph < NPHASE; ++ph) { a.ph_lo = ph; a.ph_hi = ph + 1; hipLaunchKernelGGL(hybrid_fwd, dim3(grid), dim3(512), LDS_BYTES, stream, a); }
#else
    a.ph_lo = 0; a.ph_hi = NPHASE;
    void* args[] = {&a};
    hipError_t e = hipLaunchCooperativeKernel((const void*)hybrid_fwd, dim3(grid), dim3(512), args, LDS_BYTES, stream);
    if (e != hipSuccess) fprintf(stderr, "cooperative launch failed: %s (grid %d)\n", hipGetErrorString(e), grid);
#endif
}
```
